# Optimizing an MI355X kernel written in HIP

```python
import math
import jax, jax.numpy as jnp
from jax import lax
import numpy as np


D_MODEL = 2048
BATCH = 4
SEQ = 8192
DEPTH = 2
DEC_BATCH = 1
DEC_SEQ = 16384
PAST_LEN = 128

N_EVEN = (DEPTH + 1) // 2
N_ODD = DEPTH // 2
EPS = 1e-6
A_WIDTH = D_MODEL // 2
A_HEAD = 64
A_HEADS = A_WIDTH // A_HEAD
A_DECAY_LORA = 64
A_ICL_LORA = 64
A_GATE_LORA = 128
A_COLS = 3 * A_WIDTH + 2 * A_DECAY_LORA + 2 * A_ICL_LORA + A_GATE_LORA
A_SPLITS = (A_WIDTH, 2 * A_WIDTH, 3 * A_WIDTH, 3 * A_WIDTH + 2 * A_DECAY_LORA, 3 * A_WIDTH + 2 * A_DECAY_LORA + 2 * A_ICL_LORA)
RWKV_GN_EPS = 64e-5
DECAY_SCALE = math.exp(-0.5)
B_WIDTH = D_MODEL - A_WIDTH
B_GROUP = 16
B_GROUPS = B_WIDTH // B_GROUP
B_STATE = 64
EVEN_IN = A_COLS + B_WIDTH
C_HEADS = 8
C_NOPE = 64
C_ROPE = 32
C_V = 128
C_Q_RANK = 512
C_KV_RANK = 256
ROPE_THETA = 10000.0
D_HEADS = 8
D_HEAD = 64
D_V = 2 * D_HEAD
SUBLN_EPS = 1e-5
N_BUCKETS = 32
MAX_DISTANCE = 128
ODD_SPLITS = (C_Q_RANK, C_Q_RANK + C_KV_RANK, C_Q_RANK + C_KV_RANK + C_ROPE, C_Q_RANK + C_KV_RANK + C_ROPE + D_HEADS * 2 * D_HEAD, C_Q_RANK + C_KV_RANK + C_ROPE + 2 * D_HEADS * 2 * D_HEAD)
ODD_IN = C_Q_RANK + C_KV_RANK + C_ROPE + 2 * D_HEADS * 2 * D_HEAD + D_HEADS * D_V
Q_BLOCK = 128
FFN_HIDDEN = 5632
N_MOD = 6

kernel_name = 'hybrid_bidir_rwkv7_s5_mla_diffattn_convffn_adaln'


def _f32(t):
    return t.astype(jnp.float32)


def rmsnorm(x, g, eps=EPS):
    xf = _f32(x)
    y = xf * lax.rsqrt(jnp.mean(xf * xf, axis=-1, keepdims=True) + eps)
    return (y * _f32(g)).astype(x.dtype)


def centred_shift(x):
    xp = jnp.pad(x, ((0, 0), (1, 1), (0, 0)))
    return 0.5 * (xp[:, :-2] + xp[:, 2:])


def to_blocks(t):
    b, s = t.shape[0], t.shape[1]
    return jnp.moveaxis(t.reshape((b, s // Q_BLOCK, Q_BLOCK) + t.shape[2:]), 1, 0)


def from_blocks(t):
    t = jnp.moveaxis(t, 0, 1)
    return t.reshape((t.shape[0], t.shape[1] * t.shape[2]) + t.shape[3:])


def rwkv7_scan(r, w, k, v, kk, a, reverse):
    bsz, _, h, n = r.shape
    b = a * kk
    xs = tuple(jnp.moveaxis(t, 1, 0) for t in (r, w, k, v, kk, b))

    def step(state, inp):
        r_t, w_t, k_t, v_t, kk_t, b_t = inp
        sa = jnp.einsum('bhvk,bhk->bhv', state, kk_t)
        state = state * w_t[:, :, None, :] - sa[..., None] * b_t[:, :, None, :] + v_t[..., None] * k_t[:, :, None, :]
        return state, jnp.einsum('bhvk,bhk->bhv', state, r_t)

    s0 = jnp.zeros((bsz, h, n, n), jnp.float32)
    _, ys = lax.scan(step, s0, xs, reverse=reverse)
    return jnp.moveaxis(ys, 0, 1)


def rwkv7_mixer(pa, mu, w0, w_up, a0, a_up, g_up, k_k, k_a, r_k, lnx_g, lnx_b):
    bsz, s, _ = pa.shape
    pa = pa + mu * (centred_shift(pa) - pa)
    r, k, v, dw, da, dg = jnp.split(_f32(pa), A_SPLITS, axis=-1)
    dw = dw.reshape(bsz, s, 2, A_DECAY_LORA)
    da = da.reshape(bsz, s, 2, A_ICL_LORA)
    decay = jnp.exp(-DECAY_SCALE * jax.nn.sigmoid(_f32(w0) + jnp.einsum('bsdr,drc->bsdc', jnp.tanh(dw), _f32(w_up))))
    icl = jax.nn.sigmoid(_f32(a0) + jnp.einsum('bsdr,drc->bsdc', da, _f32(a_up)))
    g = jax.nn.sigmoid(dg) @ _f32(g_up)

    def heads(t):
        return t.reshape(bsz, s, A_HEADS, A_HEAD)

    kk = heads(k * _f32(k_k))
    kk = kk / jnp.maximum(jnp.sqrt(jnp.sum(kk * kk, axis=-1, keepdims=True)), 1e-12)
    r_h, v_h = heads(r), heads(v)
    y = jnp.zeros_like(r_h)
    bonus = jnp.zeros(r_h.shape[:-1] + (1,), jnp.float32)
    for d in range(2):
        k_dh = heads(k * (1.0 + (icl[:, :, d] - 1.0) * _f32(k_a)))
        y = y + rwkv7_scan(r_h, heads(decay[:, :, d]), k_dh, v_h, kk, heads(icl[:, :, d]), reverse=(d == 1))
        bonus = bonus + jnp.sum(r_h * k_dh * _f32(r_k), axis=-1, keepdims=True)
    mean = jnp.mean(y, axis=-1, keepdims=True)
    var = jnp.mean(jnp.square(y - mean), axis=-1, keepdims=True)
    y = ((y - mean) * lax.rsqrt(var + RWKV_GN_EPS)).reshape(bsz, s, A_WIDTH) * _f32(lnx_g) + _f32(lnx_b)
    y = y + (bonus * v_h).reshape(bsz, s, A_WIDTH)
    return (y * g).astype(pa.dtype)


def _complex_combine(e1, e2):
    a1r, a1i, b1r, b1i = e1
    a2r, a2i, b2r, b2i = e2
    return (a2r * a1r - a2i * a1i,
            a2r * a1i + a2i * a1r,
            a2r * b1r - a2i * b1i + b2r,
            a2r * b1i + a2i * b1r + b2i)


def s5_mixer(u, lam_re, lam_im, log_step, b_re, b_im, c_re, c_im, d_skip, w_glu, b_glu):
    bsz, s, _ = u.shape
    uf = _f32(u).reshape(bsz, s, B_GROUPS, B_GROUP)
    y = uf * _f32(d_skip).reshape(B_GROUPS, B_GROUP)
    for d in range(2):
        lr, li = _f32(lam_re[d]), _f32(lam_im[d])
        step = jnp.exp(_f32(log_step[d]))[:, None]
        mag = jnp.exp(lr * step)
        ar, ai = mag * jnp.cos(li * step), mag * jnp.sin(li * step)
        den = lr * lr + li * li
        nr, ni = ar - 1.0, ai
        fr, fi = (nr * lr + ni * li) / den, (ni * lr - nr * li) / den
        br, bi = _f32(b_re[d]), _f32(b_im[d])
        bbr = fr[..., None] * br - fi[..., None] * bi
        bbi = fr[..., None] * bi + fi[..., None] * br
        xr = jnp.einsum('bsgc,gpc->bsgp', uf, bbr)
        xi = jnp.einsum('bsgc,gpc->bsgp', uf, bbi)
        a_r = jnp.broadcast_to(ar, (1, s, B_GROUPS, B_STATE))
        a_i = jnp.broadcast_to(ai, (1, s, B_GROUPS, B_STATE))
        _, _, hr, hi = lax.associative_scan(_complex_combine, (a_r, a_i, xr, xi), reverse=(d == 1), axis=1)
        y = y + jnp.einsum('bsgp,gcp->bsgc', hr, _f32(c_re[d])) - jnp.einsum('bsgp,gcp->bsgc', hi, _f32(c_im[d]))
    z = jax.nn.gelu(y.reshape(bsz, s, B_WIDTH))
    z = z * jax.nn.sigmoid(z @ _f32(w_glu) + _f32(b_glu))
    return z.astype(u.dtype)


def rope_tables(s, dim):
    inv = 1.0 / (ROPE_THETA ** (jnp.arange(0, dim, 2, dtype=jnp.float32) / dim))
    ang = jnp.arange(s, dtype=jnp.float32)[:, None] * inv[None, :]
    return jnp.cos(ang), jnp.sin(ang)


def apply_rope(x, cos, sin):
    x1, x2 = jnp.split(_f32(x), 2, axis=-1)
    return jnp.concatenate([x1 * cos - x2 * sin, x1 * sin + x2 * cos], axis=-1).astype(x.dtype)


def mla_mixer(cq, ckv, kr, q_norm_g, kv_norm_g, w_uq, w_ukv):
    bsz, s, _ = cq.shape
    q = (rmsnorm(cq, q_norm_g) @ w_uq).reshape(bsz, s, C_HEADS, C_NOPE + C_ROPE)
    q_nope, q_rope = q[..., :C_NOPE], q[..., C_NOPE:]
    kv = (rmsnorm(ckv, kv_norm_g) @ w_ukv).reshape(bsz, s, C_HEADS, C_NOPE + C_V)
    k_nope, v = kv[..., :C_NOPE], kv[..., C_NOPE:]
    cos, sin = rope_tables(s, C_ROPE)
    q_rope = apply_rope(q_rope, cos[:, None, :], sin[:, None, :])
    k_rope = apply_rope(kr, cos, sin)
    scale = (C_NOPE + C_ROPE) ** -0.5

    def block(args):
        qn, qr = args
        sc = jnp.einsum('bqhd,bkhd->bhqk', qn, k_nope) + jnp.einsum('bqhd,bkd->bhqk', qr, k_rope)
        p = jax.nn.softmax(_f32(sc) * scale, axis=-1)
        return jnp.einsum('bhqk,bkhd->bqhd', p.astype(v.dtype), v)

    out = from_blocks(lax.map(block, (to_blocks(q_nope), to_blocks(q_rope))))
    return out.reshape(bsz, s, C_HEADS * C_V)


def t5_bucket(rel):
    half = N_BUCKETS // 2
    max_exact = half // 2
    n = jnp.abs(rel)
    large = max_exact + (jnp.log(jnp.maximum(n, 1).astype(jnp.float32) / max_exact) / math.log(MAX_DISTANCE / max_exact) * (half - max_exact)).astype(jnp.int32)
    large = jnp.minimum(large, half - 1)
    return jnp.where(rel > 0, half, 0) + jnp.where(n < max_exact, n, large)


def diff_mixer(q, k, v, rel_bias, lq1, lk1, lq2, lk2, subln_g, lambda_init):
    bsz, s = q.shape[0], q.shape[1]
    lam = jnp.exp(jnp.sum(_f32(lq1) * _f32(lk1))) - jnp.exp(jnp.sum(_f32(lq2) * _f32(lk2))) + lambda_init
    scale = D_HEAD ** -0.5
    kpos = jnp.arange(s, dtype=jnp.int32)

    def block(args):
        qb, blk = args
        qpos = blk * Q_BLOCK + jnp.arange(Q_BLOCK, dtype=jnp.int32)
        bias = jnp.moveaxis(_f32(rel_bias)[t5_bucket(kpos[None, :] - qpos[:, None])], -1, 0)
        sc = _f32(jnp.einsum('bqhmd,bkhmd->bhmqk', qb, k)) * scale + bias[None, :, None]
        p = jax.nn.softmax(sc, axis=-1)
        attn = p[:, :, 0] - lam * p[:, :, 1]
        return jnp.einsum('bhqk,bkhd->bqhd', attn.astype(v.dtype), v)

    nb = s // Q_BLOCK
    out = from_blocks(lax.map(block, (to_blocks(q), jnp.arange(nb, dtype=jnp.int32))))
    out = rmsnorm(out, subln_g, SUBLN_EPS) * (1.0 - lambda_init)
    return out.reshape(bsz, s, D_HEADS * D_V)


def conv_ffn(h, w_up, conv_w, conv_b, w_down):
    u = h @ w_up
    up = jnp.pad(u, ((0, 0), (1, 1), (0, 0)))
    u = up[:, :-2] * conv_w[0] + up[:, 1:-1] * conv_w[1] + up[:, 2:] * conv_w[2] + conv_b
    val, gate = jnp.split(u, 2, axis=-1)
    return (jax.nn.silu(gate) * val) @ w_down


def trunk(x, c, ada_w, ada_b, norm1_g, norm2_g, even_w_in, even_w_out,
          rwkv_mu, rwkv_w0, rwkv_w_up, rwkv_a0, rwkv_a_up, rwkv_g_up, rwkv_k_k, rwkv_k_a, rwkv_r_k, rwkv_lnx_g, rwkv_lnx_b,
          s5_lam_re, s5_lam_im, s5_log_step, s5_b_re, s5_b_im, s5_c_re, s5_c_im, s5_d, s5_w_glu, s5_b_glu,
          odd_w_in, odd_w_out, mla_q_norm_g, mla_kv_norm_g, mla_w_uq, mla_w_ukv,
          diff_lq1, diff_lk1, diff_lq2, diff_lk2, diff_subln_g, rel_bias,
          ffn_w_up, ffn_conv_w, ffn_conv_b, ffn_w_down, final_g):
    cs = jax.nn.silu(c)
    for i in range(DEPTH):
        mod = cs @ ada_w[i] + ada_b[i]
        sh1, sc1, g1, sh2, sc2, g2 = [m[:, None, :] for m in jnp.split(mod, N_MOD, axis=-1)]
        h = rmsnorm(x, norm1_g[i]) * (1.0 + sc1) + sh1
        j = i // 2
        if i % 2 == 0:
            p = h @ even_w_in[j]
            ya = rwkv7_mixer(p[..., :A_COLS], rwkv_mu[j], rwkv_w0[j], rwkv_w_up[j], rwkv_a0[j], rwkv_a_up[j], rwkv_g_up[j],
                             rwkv_k_k[j], rwkv_k_a[j], rwkv_r_k[j], rwkv_lnx_g[j], rwkv_lnx_b[j])
            yb = s5_mixer(p[..., A_COLS:], s5_lam_re[j], s5_lam_im[j], s5_log_step[j], s5_b_re[j], s5_b_im[j],
                          s5_c_re[j], s5_c_im[j], s5_d[j], s5_w_glu[j], s5_b_glu[j])
            mix = jnp.concatenate([ya, yb], axis=-1) @ even_w_out[j]
        else:
            p = h @ odd_w_in[j]
            bsz, s = p.shape[0], p.shape[1]
            cq, ckv, kr, dq, dk, dv = jnp.split(p, ODD_SPLITS, axis=-1)
            yc = mla_mixer(cq, ckv, kr, mla_q_norm_g[j], mla_kv_norm_g[j], mla_w_uq[j], mla_w_ukv[j])
            yd = diff_mixer(dq.reshape(bsz, s, D_HEADS, 2, D_HEAD), dk.reshape(bsz, s, D_HEADS, 2, D_HEAD),
                            dv.reshape(bsz, s, D_HEADS, D_V), rel_bias, diff_lq1[j], diff_lk1[j], diff_lq2[j], diff_lk2[j],
                            diff_subln_g[j], 0.8 - 0.6 * math.exp(-0.3 * i))
            mix = jnp.concatenate([yc, yd], axis=-1) @ odd_w_out[j]
        x = x + g1 * mix
        h = rmsnorm(x, norm2_g[i]) * (1.0 + sc2) + sh2
        x = x + g2 * conv_ffn(h, ffn_w_up[i], ffn_conv_w[i], ffn_conv_b[i], ffn_w_down[i])
    return rmsnorm(x, final_g)


def setup_inputs(seed: int = 0) -> dict:
    key = jax.random.key(seed)
    ks = iter(jax.random.split(key, 64))

    def nrm(shape, s):
        return jax.random.normal(next(ks), shape, jnp.float32) * s

    def uni(shape, lo, hi):
        return jax.random.uniform(next(ks), shape, jnp.float32, lo, hi)

    D = D_MODEL
    inp = {}
    inp['x_prompt'] = nrm((BATCH, SEQ, D), 1.0)
    inp['x_sample'] = nrm((DEC_BATCH, DEC_SEQ, D), 1.0)
    inp['c_prompt'] = nrm((BATCH, D), 1.0)
    inp['c_sample'] = nrm((DEC_BATCH, D), 1.0)
    inp['ada_w'] = nrm((DEPTH, D, N_MOD * D), 0.5 * D ** -0.5)
    inp['ada_b'] = nrm((DEPTH, N_MOD * D), 0.02)
    inp['norm1_g'] = 1.0 + nrm((DEPTH, D), 0.02)
    inp['norm2_g'] = 1.0 + nrm((DEPTH, D), 0.02)
    inp['even_w_in'] = nrm((N_EVEN, D, EVEN_IN), D ** -0.5)
    inp['even_w_out'] = nrm((N_EVEN, A_WIDTH + B_WIDTH, D), (A_WIDTH + B_WIDTH) ** -0.5)
    inp['rwkv_mu'] = uni((N_EVEN, A_COLS), 0.0, 1.0)
    inp['rwkv_w0'] = uni((N_EVEN, 2, A_WIDTH), -6.0, 1.0)
    inp['rwkv_w_up'] = nrm((N_EVEN, 2, A_DECAY_LORA, A_WIDTH), 0.1)
    inp['rwkv_a0'] = nrm((N_EVEN, 2, A_WIDTH), 0.1)
    inp['rwkv_a_up'] = nrm((N_EVEN, 2, A_ICL_LORA, A_WIDTH), 0.5 * A_ICL_LORA ** -0.5)
    inp['rwkv_g_up'] = nrm((N_EVEN, A_GATE_LORA, A_WIDTH), A_GATE_LORA ** -0.5)
    inp['rwkv_k_k'] = 0.85 + nrm((N_EVEN, A_WIDTH), 0.05)
    inp['rwkv_k_a'] = 1.0 + nrm((N_EVEN, A_WIDTH), 0.05)
    inp['rwkv_r_k'] = nrm((N_EVEN, A_HEADS, A_HEAD), 0.1)
    inp['rwkv_lnx_g'] = 1.0 + nrm((N_EVEN, A_WIDTH), 0.02)
    inp['rwkv_lnx_b'] = nrm((N_EVEN, A_WIDTH), 0.02)
    inp['s5_lam_re'] = -0.5 + nrm((N_EVEN, 2, B_GROUPS, B_STATE), 0.01)
    inp['s5_lam_im'] = jnp.pi * jnp.arange(B_STATE, dtype=jnp.float32) + nrm((N_EVEN, 2, B_GROUPS, B_STATE), 0.01)
    inp['s5_log_step'] = uni((N_EVEN, 2, B_GROUPS), math.log(1e-3), math.log(1e-1))
    inp['s5_b_re'] = nrm((N_EVEN, 2, B_GROUPS, B_STATE, B_GROUP), (2 * B_GROUP) ** -0.5)
    inp['s5_b_im'] = nrm((N_EVEN, 2, B_GROUPS, B_STATE, B_GROUP), (2 * B_GROUP) ** -0.5)
    inp['s5_c_re'] = nrm((N_EVEN, 2, B_GROUPS, B_GROUP, B_STATE), B_STATE ** -0.5)
    inp['s5_c_im'] = nrm((N_EVEN, 2, B_GROUPS, B_GROUP, B_STATE), B_STATE ** -0.5)
    inp['s5_d'] = nrm((N_EVEN, B_WIDTH), 1.0)
    inp['s5_w_glu'] = nrm((N_EVEN, B_WIDTH, B_WIDTH), B_WIDTH ** -0.5)
    inp['s5_b_glu'] = nrm((N_EVEN, B_WIDTH), 0.02)
    inp['odd_w_in'] = nrm((N_ODD, D, ODD_IN), D ** -0.5)
    inp['odd_w_out'] = nrm((N_ODD, C_HEADS * C_V + D_HEADS * D_V, D), (C_HEADS * C_V + D_HEADS * D_V) ** -0.5)
    inp['mla_q_norm_g'] = 1.0 + nrm((N_ODD, C_Q_RANK), 0.02)
    inp['mla_kv_norm_g'] = 1.0 + nrm((N_ODD, C_KV_RANK), 0.02)
    inp['mla_w_uq'] = nrm((N_ODD, C_Q_RANK, C_HEADS * (C_NOPE + C_ROPE)), C_Q_RANK ** -0.5)
    inp['mla_w_ukv'] = nrm((N_ODD, C_KV_RANK, C_HEADS * (C_NOPE + C_V)), C_KV_RANK ** -0.5)
    inp['diff_lq1'] = nrm((N_ODD, D_HEAD), 0.1)
    inp['diff_lk1'] = nrm((N_ODD, D_HEAD), 0.1)
    inp['diff_lq2'] = nrm((N_ODD, D_HEAD), 0.1)
    inp['diff_lk2'] = nrm((N_ODD, D_HEAD), 0.1)
    inp['diff_subln_g'] = 1.0 + nrm((N_ODD, D_V), 0.02)
    inp['rel_bias'] = nrm((N_BUCKETS, D_HEADS), 0.5)
    inp['ffn_w_up'] = nrm((DEPTH, D, 2 * FFN_HIDDEN), D ** -0.5)
    inp['ffn_conv_w'] = jnp.array([0.25, 0.5, 0.25], jnp.float32)[None, :, None] + nrm((DEPTH, 3, 2 * FFN_HIDDEN), 0.1)
    inp['ffn_conv_b'] = nrm((DEPTH, 2 * FFN_HIDDEN), 0.02)
    inp['ffn_w_down'] = nrm((DEPTH, FFN_HIDDEN, D), FFN_HIDDEN ** -0.5)
    inp['final_g'] = 1.0 + nrm((D,), 0.02)
    return inp


def reference(x_prompt, x_sample, c_prompt, c_sample, ada_w, ada_b, norm1_g, norm2_g, even_w_in, even_w_out,
              rwkv_mu, rwkv_w0, rwkv_w_up, rwkv_a0, rwkv_a_up, rwkv_g_up, rwkv_k_k, rwkv_k_a, rwkv_r_k, rwkv_lnx_g, rwkv_lnx_b,
              s5_lam_re, s5_lam_im, s5_log_step, s5_b_re, s5_b_im, s5_c_re, s5_c_im, s5_d, s5_w_glu, s5_b_glu,
              odd_w_in, odd_w_out, mla_q_norm_g, mla_kv_norm_g, mla_w_uq, mla_w_ukv,
              diff_lq1, diff_lk1, diff_lq2, diff_lk2, diff_subln_g, rel_bias,
              ffn_w_up, ffn_conv_w, ffn_conv_b, ffn_w_down, final_g):
    weights = (ada_w, ada_b, norm1_g, norm2_g, even_w_in, even_w_out,
               rwkv_mu, rwkv_w0, rwkv_w_up, rwkv_a0, rwkv_a_up, rwkv_g_up, rwkv_k_k, rwkv_k_a, rwkv_r_k, rwkv_lnx_g, rwkv_lnx_b,
               s5_lam_re, s5_lam_im, s5_log_step, s5_b_re, s5_b_im, s5_c_re, s5_c_im, s5_d, s5_w_glu, s5_b_glu,
               odd_w_in, odd_w_out, mla_q_norm_g, mla_kv_norm_g, mla_w_uq, mla_w_ukv,
               diff_lq1, diff_lk1, diff_lq2, diff_lk2, diff_subln_g, rel_bias,
               ffn_w_up, ffn_conv_w, ffn_conv_b, ffn_w_down, final_g)
    y_prompt = trunk(x_prompt, c_prompt, *weights)
    y_sample = trunk(x_sample, c_sample, *weights)
    return (y_prompt, y_sample)
```

```cpp
#include <hip/hip_runtime.h>
#include <hip/hip_cooperative_groups.h>
#include <cstdio>
#include <cstdint>
namespace cg = cooperative_groups;
typedef _Float16 hf;
using h8 = __attribute__((ext_vector_type(8))) _Float16;
using h4 = __attribute__((ext_vector_type(4))) _Float16;
using f4 = __attribute__((ext_vector_type(4))) float;
using u4 = __attribute__((ext_vector_type(4))) unsigned;

#define T_TOK 49152
#ifndef STOP_AT
#define STOP_AT 100
#endif
#define DI __device__ __forceinline__
constexpr size_t MiB = 1ull << 20;

struct Params {
  const float* in[48];
  float* out;
  char* ws;
  long stop;
};

constexpr size_t OFF_W = 0;
constexpr size_t OFF_RA = 96 * MiB;
constexpr size_t OFF_RB = 288 * MiB;
constexpr size_t OFF_US5 = 612 * MiB;
constexpr size_t OFF_MIX0 = 756 * MiB;
constexpr size_t OFF_S5M = 948 * MiB;
constexpr size_t OFF_SMALL = 1012 * MiB;
constexpr size_t OFF_ACT = 640 * MiB;
constexpr size_t OFF_VTD = 555 * MiB;
constexpr size_t OFF_VTM = 651 * MiB;
constexpr size_t OFF_MIX1 = 747 * MiB;
constexpr size_t SM_MOD = 0;
constexpr size_t SM_CNT = 512 * 1024;
constexpr size_t SM_KTAB = 1 * MiB;
constexpr size_t SM_BONUS = 5 * MiB;
constexpr size_t W0_IN = 0, W0_OUT = 9175040, W0_GLU = 13369344, W0_GUP = 14417920, W0_FUP = 14548992, W0_FDN = 37617664;
constexpr size_t W1_IN = 0, W1_OUT = 7929856, W1_UQ = 12124160, W1_UKV = 12517376, W1_FUP = 12910592, W1_FDN = 35979264;

DI int seq_of(int t) { return t < 32768 ? (t >> 13) : 4; }
DI int seq_start(int s) { return s < 4 ? s * 8192 : 32768; }
DI int seq_len(int s) { return s < 4 ? 8192 : 16384; }
DI float sigmoidf_(float x) { return 1.f / (1.f + __expf(-x)); }
DI h4 cvt4(f4 v) { h4 r; r[0] = (hf)v[0]; r[1] = (hf)v[1]; r[2] = (hf)v[2]; r[3] = (hf)v[3]; return r; }
DI void sincos_red(float x, float& s, float& c) {
  double a = (double)x; double n = rint(a * 0.15915494309189535); float r = (float)(a - n * 6.283185307179586);
  s = __sinf(r); c = __cosf(r);
}
DI float allred16(float x) {
  x += __builtin_bit_cast(float, __builtin_amdgcn_update_dpp(0, __builtin_bit_cast(int, x), 0x128, 0xf, 0xf, false));
  x += __builtin_bit_cast(float, __builtin_amdgcn_update_dpp(0, __builtin_bit_cast(int, x), 0x124, 0xf, 0xf, false));
  x += __builtin_bit_cast(float, __builtin_amdgcn_update_dpp(0, __builtin_bit_cast(int, x), 0x122, 0xf, 0xf, false));
  x += __builtin_bit_cast(float, __builtin_amdgcn_update_dpp(0, __builtin_bit_cast(int, x), 0x121, 0xf, 0xf, false));
  return x;
}
DI f4 mfma16(h8 a, h8 b, f4 c) { return __builtin_amdgcn_mfma_f32_16x16x32_f16(a, b, c, 0, 0, 0); }

__device__ void cvt_t(const float* __restrict__ src, hf* __restrict__ dst, int K, int N, char* smem) {
  float* tile = (float*)smem;
  const int tk = K >> 6, tn = N >> 5, total = tk * tn, tid = threadIdx.x;
  for (int t = blockIdx.x; t < total; t += gridDim.x) {
    int kt = t / tn, nt = t - kt * tn;
    __syncthreads();
    int n = tid & 31, kr = tid >> 5;
#pragma unroll
    for (int i = 0; i < 8; ++i) tile[(kr + 8 * i) * 33 + n] = src[(size_t)(kt * 64 + kr + 8 * i) * N + nt * 32 + n];
    __syncthreads();
    int on = tid >> 3, ok = (tid & 7) * 8;
    h8 o;
#pragma unroll
    for (int e = 0; e < 8; ++e) o[e] = (hf)tile[(ok + e) * 33 + on];
    *(h8*)(dst + (size_t)(nt * 32 + on) * K + kt * 64 + ok) = o;
  }
}

__device__ void adaln_phase(const Params& p, char* smem) {
  float* scs = (float*)smem;
  float* red = scs + 5 * 2048;
  float* mod = (float*)(p.ws + OFF_SMALL + SM_MOD);
  const int tid = threadIdx.x;
  __syncthreads();
  for (int i = tid; i < 5 * 2048; i += 256) {
    int s = i >> 11, k = i & 2047;
    float c = s < 4 ? p.in[2][s * 2048 + k] : p.in[3][k];
    scs[i] = c / (1.f + __expf(-c));
  }
  __syncthreads();
  for (int item = blockIdx.x; item < 384; item += gridDim.x) {
    int layer = item / 192, cb = item % 192, cl = tid & 63, kp = tid >> 6, col = cb * 64 + cl;
    const float* w = p.in[4] + (size_t)layer * 2048 * 12288 + col;
    float a0 = 0, a1 = 0, a2 = 0, a3 = 0, a4 = 0;
#pragma unroll 8
    for (int k = kp * 512; k < kp * 512 + 512; ++k) {
      float wv = w[(size_t)k * 12288];
      a0 += scs[k] * wv; a1 += scs[2048 + k] * wv; a2 += scs[4096 + k] * wv; a3 += scs[6144 + k] * wv; a4 += scs[8192 + k] * wv;
    }
    red[(kp * 5 + 0) * 64 + cl] = a0; red[(kp * 5 + 1) * 64 + cl] = a1; red[(kp * 5 + 2) * 64 + cl] = a2;
    red[(kp * 5 + 3) * 64 + cl] = a3; red[(kp * 5 + 4) * 64 + cl] = a4;
    __syncthreads();
    if (kp == 0) {
      float bb = p.in[5][layer * 12288 + col];
#pragma unroll
      for (int s = 0; s < 5; ++s)
        mod[(size_t)(layer * 5 + s) * 12288 + col] = red[s * 64 + cl] + red[(5 + s) * 64 + cl] + red[(10 + s) * 64 + cl] + red[(15 + s) * 64 + cl] + bb;
    }
    __syncthreads();
  }
}

__device__ void s5_tabA(const Params& p, char* smem) {
  float* apow = (float*)smem;
  float* BB = apow + 33 * 128;
  float* CC = BB + 2048;
  float* sF = CC + 2048;
  float* Ktab = (float*)(p.ws + OFF_SMALL + SM_KTAB);
  hf* Bt1 = (hf*)(p.ws + OFF_S5M);
  hf* Bt2 = (hf*)(p.ws + OFF_S5M + 16 * MiB);
  const int tid = threadIdx.x;
  for (int item = blockIdx.x; item < 128; item += gridDim.x) {
    int g = item >> 1, d = item & 1;
    __syncthreads();
    if (tid < 64) {
      int pp = tid;
      float step = __expf(p.in[23][d * 64 + g]);
      float lr = p.in[21][(d * 64 + g) * 64 + pp], li = p.in[22][(d * 64 + g) * 64 + pp];
      float mag = __expf(lr * step), sn, cs; sincos_red(li * step, sn, cs);
      float ar = mag * cs, ai = mag * sn, den = lr * lr + li * li, nr = ar - 1.f, ni = ai;
      sF[pp * 2] = (nr * lr + ni * li) / den; sF[pp * 2 + 1] = (ni * lr - nr * li) / den;
      float pr = 1.f, pi = 0.f;
      for (int tau = 0; tau <= 32; ++tau) {
        apow[(tau * 64 + pp) * 2] = pr; apow[(tau * 64 + pp) * 2 + 1] = pi;
        float nr2 = pr * ar - pi * ai, ni2 = pr * ai + pi * ar; pr = nr2; pi = ni2;
      }
    }
    __syncthreads();
    for (int idx = tid; idx < 1024; idx += 256) {
      int pp = idx >> 4, c = idx & 15;
      float br = p.in[24][((size_t)(d * 64 + g) * 64 + pp) * 16 + c], bi = p.in[25][((size_t)(d * 64 + g) * 64 + pp) * 16 + c];
      float fr = sF[pp * 2], fi = sF[pp * 2 + 1];
      BB[idx * 2] = fr * br - fi * bi; BB[idx * 2 + 1] = fr * bi + fi * br;
      int c2 = idx >> 6, p2 = idx & 63;
      CC[idx * 2] = p.in[26][((size_t)(d * 64 + g) * 16 + c2) * 64 + p2]; CC[idx * 2 + 1] = p.in[27][((size_t)(d * 64 + g) * 16 + c2) * 64 + p2];
    }
    __syncthreads();
    {
      int c = tid >> 4, c1 = tid & 15;
      for (int tau = 0; tau < 32; ++tau) {
        float acc = 0.f;
        for (int pp = 0; pp < 64; ++pp) {
          float cr = CC[(c * 64 + pp) * 2], ci = CC[(c * 64 + pp) * 2 + 1];
          float pr = apow[(tau * 64 + pp) * 2], pi = apow[(tau * 64 + pp) * 2 + 1];
          float wr = cr * pr - ci * pi, wi = cr * pi + ci * pr;
          acc += wr * BB[(pp * 16 + c1) * 2] - wi * BB[(pp * 16 + c1) * 2 + 1];
        }
        Ktab[((size_t)(g * 2 + d) * 32 + tau) * 256 + c * 16 + c1] = acc;
      }
    }
    for (int idx = tid; idx < 128 * 512; idx += 256) {
      int nl = idx >> 9, k = idx & 511, ri = nl >> 6, pp = nl & 63, s = k >> 4, c1 = k & 15;
      int e = d == 0 ? 31 - s : s;
      float pr = apow[(e * 64 + pp) * 2], pi = apow[(e * 64 + pp) * 2 + 1];
      float br = BB[(pp * 16 + c1) * 2], bi = BB[(pp * 16 + c1) * 2 + 1];
      float v = ri ? (pr * bi + pi * br) : (pr * br - pi * bi);
      Bt1[((size_t)g * 256 + d * 128 + nl) * 512 + k] = (hf)(v * 256.f);
    }
    for (int idx = tid; idx < 512 * 128; idx += 256) {
      int n = idx >> 7, kk = idx & 127, ri = kk >> 6, pp = kk & 63, t = n >> 4, c = n & 15;
      int pw = d == 0 ? t + 1 : 32 - t;
      float cr = CC[(c * 64 + pp) * 2], ci = CC[(c * 64 + pp) * 2 + 1];
      float pr = apow[(pw * 64 + pp) * 2], pi = apow[(pw * 64 + pp) * 2 + 1];
      float v = ri ? -(cr * pi + ci * pr) : (cr * pr - ci * pi);
      Bt2[((size_t)g * 512 + n) * 768 + 512 + d * 128 + kk] = (hf)v;
    }
  }
}

__device__ void s5_tabB(const Params& p) {
  const float* Ktab = (const float*)(p.ws + OFF_SMALL + SM_KTAB);
  hf* Bt2 = (hf*)(p.ws + OFF_S5M + 16 * MiB);
  const float* dsk = p.in[28];
  for (int idx = blockIdx.x * 256 + threadIdx.x; idx < 64 * 512 * 64; idx += gridDim.x * 256) {
    int kc = idx & 63, n = (idx >> 6) & 511, g = idx >> 15;
    int t = n >> 4, c = n & 15, s = kc >> 1, c0 = (kc & 1) * 8;
    h8 o;
    if (t != s) {
      int d = t > s ? 0 : 1, tau = t > s ? t - s : s - t;
      const float* kp = Ktab + ((size_t)(g * 2 + d) * 32 + tau) * 256 + c * 16 + c0;
#pragma unroll
      for (int e = 0; e < 8; ++e) o[e] = (hf)(kp[e] * 256.f);
    } else {
      const float* k0 = Ktab + ((size_t)(g * 2 + 0) * 32) * 256 + c * 16 + c0;
      const float* k1 = Ktab + ((size_t)(g * 2 + 1) * 32) * 256 + c * 16 + c0;
      float ds = dsk[g * 16 + c];
#pragma unroll
      for (int e = 0; e < 8; ++e) o[e] = (hf)((k0[e] + k1[e] + ((c0 + e) == c ? ds : 0.f)) * 256.f);
    }
    *(h8*)(Bt2 + ((size_t)g * 512 + n) * 768 + kc * 8) = o;
  }
}

__device__ void s5_carry(const Params& p) {
  const float* E = (const float*)(p.ws + OFF_RA);
  hf* us5 = (hf*)(p.ws + OFF_US5);
  for (int idx = blockIdx.x * 256 + threadIdx.x; idx < 64 * 5 * 2 * 64; idx += gridDim.x * 256) {
    int pp = idx & 63, dd = (idx >> 6) & 1, sq = (idx >> 7) % 5, g = idx / 640;
    float step = __expf(p.in[23][dd * 64 + g]);
    float lr = p.in[21][(dd * 64 + g) * 64 + pp], li = p.in[22][(dd * 64 + g) * 64 + pp];
    float mag = __expf(lr * step), sn, cs; sincos_red(li * step, sn, cs);
    float ar = mag * cs, ai = mag * sn;
#pragma unroll
    for (int i = 0; i < 5; ++i) { float r2 = ar * ar - ai * ai, i2 = 2.f * ar * ai; ar = r2; ai = i2; }
    int c0 = seq_start(sq) >> 5, nc = seq_len(sq) >> 5;
    float cr = 0.f, ci = 0.f;
    int n = dd * 128 + pp;
    for (int j0 = 0; j0 < nc; j0 += 8) {
      float er[8], ei[8];
#pragma unroll
      for (int u = 0; u < 8; ++u) {
        int j = dd == 0 ? (j0 + u) : (nc - 1 - j0 - u);
        size_t o = ((size_t)g * 1536 + c0 + j) * 256 + n;
        er[u] = E[o]; ei[u] = E[o + 64];
      }
#pragma unroll
      for (int u = 0; u < 8; ++u) {
        int j = dd == 0 ? (j0 + u) : (nc - 1 - j0 - u);
        size_t o = ((size_t)g * 1536 + c0 + j) * 768 + 512 + n;
        us5[o] = (hf)cr; us5[o + 64] = (hf)ci;
        float nr = ar * cr - ai * ci + er[u], ni = ar * ci + ai * cr + ei[u]; cr = nr; ci = ni;
      }
    }
  }
}

__device__ void norm_phase(const Params& p, int layer, int which, bool from_inputs) {
  const float* mod = (const float*)(p.ws + OFF_SMALL + SM_MOD) + (size_t)layer * 5 * 12288;
  const float* gain = (which == 0 ? p.in[6] : p.in[7]) + layer * 2048;
  hf* h16 = (hf*)(p.ws + OFF_RA);
  const int lane = threadIdx.x & 63, gw = blockIdx.x * 4 + (threadIdx.x >> 6), nw = gridDim.x * 4;
  const int o_sh = which == 0 ? 0 : 3 * 2048, o_sc = o_sh + 2048;
  for (int t = gw; t < T_TOK; t += nw) {
    const float* xr = from_inputs ? (t < 32768 ? p.in[0] + (size_t)t * 2048 : p.in[1] + (size_t)(t - 32768) * 2048) : p.out + (size_t)t * 2048;
    float4 v[8]; float ss = 0.f;
#pragma unroll
    for (int i = 0; i < 8; ++i) { v[i] = ((const float4*)xr)[i * 64 + lane]; ss += v[i].x * v[i].x + v[i].y * v[i].y + v[i].z * v[i].z + v[i].w * v[i].w; }
#pragma unroll
    for (int o = 32; o; o >>= 1) ss += __shfl_xor(ss, o);
    float r = rsqrtf(ss * (1.f / 2048.f) + 1e-6f);
    const float* m = mod + (size_t)seq_of(t) * 12288;
#pragma unroll
    for (int i = 0; i < 8; ++i) {
      int idx = (i * 64 + lane) * 4;
      float4 g4 = *(const float4*)(gain + idx), sc = *(const float4*)(m + o_sc + idx), sh = *(const float4*)(m + o_sh + idx);
      h4 o;
      o[0] = (hf)(v[i].x * r * g4.x * (1.f + sc.x) + sh.x); o[1] = (hf)(v[i].y * r * g4.y * (1.f + sc.y) + sh.y);
      o[2] = (hf)(v[i].z * r * g4.z * (1.f + sc.z) + sh.z); o[3] = (hf)(v[i].w * r * g4.w * (1.f + sc.w) + sh.w);
      *(h4*)(h16 + (size_t)t * 2048 + idx) = o;
      if (from_inputs) *(float4*)(p.out + (size_t)t * 2048 + idx) = v[i];
    }
  }
}

__device__ void final_norm(const Params& p) {
  const int lane = threadIdx.x & 63, gw = blockIdx.x * 4 + (threadIdx.x >> 6), nw = gridDim.x * 4;
  for (int t = gw; t < T_TOK; t += nw) {
    float* xr = p.out + (size_t)t * 2048;
    float4 v[8]; float ss = 0.f;
#pragma unroll
    for (int i = 0; i < 8; ++i) { v[i] = ((const float4*)xr)[i * 64 + lane]; ss += v[i].x * v[i].x + v[i].y * v[i].y + v[i].z * v[i].z + v[i].w * v[i].w; }
#pragma unroll
    for (int o = 32; o; o >>= 1) ss += __shfl_xor(ss, o);
    float r = rsqrtf(ss * (1.f / 2048.f) + 1e-6f);
#pragma unroll
    for (int i = 0; i < 8; ++i) {
      int idx = (i * 64 + lane) * 4;
      float4 g4 = *(const float4*)(p.in[47] + idx);
      float4 o; o.x = v[i].x * r * g4.x; o.y = v[i].y * r * g4.y; o.z = v[i].z * r * g4.z; o.w = v[i].w * r * g4.w;
      *(float4*)(xr + idx) = o;
    }
  }
}

struct GemmArgs { const hf* A; size_t lda, sA; const hf* Bt; size_t ldb, sB; int M, N, K, nb; };

#define EPI_BEGIN _Pragma("unroll") for (int mi = 0; mi < 4; ++mi) _Pragma("unroll") for (int ni = 0; ni < 4; ++ni) { \
    const int row = row0 + mi * 16 + fr; const int c = col0 + ni * 16 + fq * 4; const f4 v = acc[mi][ni]; (void)row; (void)c; (void)b;
#define EPI_END }

template <class Epi>
__device__ __forceinline__ void gemm_run(const GemmArgs g, Epi epi, char* smem) {
  hf* sA = (hf*)smem; hf* sB = sA + 128 * 72;
  const int tid = threadIdx.x, lane = tid & 63, wv = tid >> 6, wm = wv >> 1, wn = wv & 1, fr = lane & 15, fq = lane >> 4;
  const int tm = g.M >> 7, tn = (g.N + 127) >> 7, per = tm * tn, total = per * g.nb, nk = g.K >> 6;
  const int lr = tid >> 3, lc = (tid & 7) * 8;
  for (int tile = blockIdx.x; tile < total; tile += gridDim.x) {
    const int b = tile / per, r = tile - b * per;
    const int grp = r / (16 * tn), rem = r - grp * 16 * tn, m0 = grp * 16, gm = min(16, tm - m0);
    const int nt = rem / gm, mt = m0 + rem % gm;
    const hf* Ap = g.A + (size_t)b * g.sA + (size_t)(mt * 128 + lr) * g.lda + lc;
    const hf* Bp = g.Bt + (size_t)b * g.sB + lc;
    size_t brow[4];
#pragma unroll
    for (int i = 0; i < 4; ++i) brow[i] = (size_t)min(nt * 128 + lr + 32 * i, g.N - 1) * g.ldb;
    u4 ra[4], rb[4];
#pragma unroll
    for (int i = 0; i < 4; ++i) { ra[i] = *(const u4*)(Ap + (size_t)(32 * i) * g.lda); rb[i] = *(const u4*)(Bp + brow[i]); }
    f4 acc[4][4];
#pragma unroll
    for (int i = 0; i < 4; ++i)
#pragma unroll
      for (int j = 0; j < 4; ++j) acc[i][j] = (f4){0.f, 0.f, 0.f, 0.f};
    for (int kt = 0; kt < nk; ++kt) {
      __syncthreads();
#pragma unroll
      for (int i = 0; i < 4; ++i) { *(u4*)(sA + (lr + 32 * i) * 72 + lc) = ra[i]; *(u4*)(sB + (lr + 32 * i) * 72 + lc) = rb[i]; }
      __syncthreads();
      if (kt + 1 < nk) {
        const int ko = (kt + 1) * 64;
#pragma unroll
        for (int i = 0; i < 4; ++i) { ra[i] = *(const u4*)(Ap + (size_t)(32 * i) * g.lda + ko); rb[i] = *(const u4*)(Bp + brow[i] + ko); }
      }
#pragma unroll
      for (int ks = 0; ks < 2; ++ks) {
        h8 af[4], bf[4];
#pragma unroll
        for (int i = 0; i < 4; ++i) {
          af[i] = *(const h8*)(sA + (wm * 64 + i * 16 + fr) * 72 + ks * 32 + fq * 8);
          bf[i] = *(const h8*)(sB + (wn * 64 + i * 16 + fr) * 72 + ks * 32 + fq * 8);
        }
#pragma unroll
        for (int mi = 0; mi < 4; ++mi)
#pragma unroll
          for (int ni = 0; ni < 4; ++ni) acc[mi][ni] = mfma16(bf[ni], af[mi], acc[mi][ni]);
      }
    }
    epi(acc, b, mt * 128 + wm * 64, nt * 128 + wn * 64, fr, fq);
  }
}

struct EpiInproj0 { hf* prw; hf* us5;
  DI void operator()(f4 (&acc)[4][4], int b, int row0, int col0, int fr, int fq) const {
    EPI_BEGIN
      if (c < 3456) *(h4*)(prw + (size_t)row * 3456 + c) = cvt4(v);
      else { int cu = c - 3456, g = cu >> 4, cc = cu & 15; *(h4*)(us5 + ((size_t)g * 1536 + (row >> 5)) * 768 + (row & 31) * 16 + cc) = cvt4(v); }
    EPI_END } };
struct EpiS5p1 { float* E;
  DI void operator()(f4 (&acc)[4][4], int b, int row0, int col0, int fr, int fq) const {
    EPI_BEGIN
      *(f4*)(E + ((size_t)b * 1536 + row) * 256 + c) = v;
    EPI_END } };
struct EpiS5p2 { hf* z16;
  DI void operator()(f4 (&acc)[4][4], int b, int row0, int col0, int fr, int fq) const {
    EPI_BEGIN
      int tok = row * 32 + (c >> 4), cc = c & 15; h4 o;
#pragma unroll
      for (int j = 0; j < 4; ++j) { float y = v[j] * (1.f / 256.f); float u = 0.7978845608f * (y + 0.044715f * y * y * y); float th = 1.f - 2.f / (1.f + __expf(2.f * u)); o[j] = (hf)(0.5f * y * (1.f + th)); }
      *(h4*)(z16 + (size_t)tok * 1024 + b * 16 + cc) = o;
    EPI_END } };
struct EpiGlu { const hf* z16; const float* bglu; hf* mix;
  DI void operator()(f4 (&acc)[4][4], int b, int row0, int col0, int fr, int fq) const {
    EPI_BEGIN
      h4 z = *(const h4*)(z16 + (size_t)row * 1024 + c); f4 bb = *(const f4*)(bglu + c); h4 o;
#pragma unroll
      for (int j = 0; j < 4; ++j) o[j] = (hf)((float)z[j] * sigmoidf_(v[j] + bb[j]));
      *(h4*)(mix + (size_t)row * 2048 + 1024 + c) = o;
    EPI_END } };
struct EpiStore { hf* dst; size_t ld;
  DI void operator()(f4 (&acc)[4][4], int b, int row0, int col0, int fr, int fq) const {
    EPI_BEGIN
      *(h4*)(dst + (size_t)row * ld + c) = cvt4(v);
    EPI_END } };
struct EpiResid { float* x; const float* gate; int tok0;
  DI void operator()(f4 (&acc)[4][4], int b, int row0, int col0, int fr, int fq) const {
    EPI_BEGIN
      int tok = tok0 + row; const float* gp = gate + (size_t)seq_of(tok) * 12288 + c; f4 gg = *(const f4*)gp;
      f4* xp = (f4*)(x + (size_t)tok * 2048 + c); f4 xv = *xp;
      xv[0] += gg[0] * v[0]; xv[1] += gg[1] * v[1]; xv[2] += gg[2] * v[2]; xv[3] += gg[3] * v[3]; *xp = xv;
    EPI_END } };
struct EpiInproj1 { hf* p1; hf* vtd;
  DI void operator()(f4 (&acc)[4][4], int b, int row0, int col0, int fr, int fq) const {
    EPI_BEGIN
      if (c < 2848) *(h4*)(p1 + (size_t)row * 2848 + c) = cvt4(v);
      else if (c < 3872) { int cd = c - 2848;
#pragma unroll
        for (int j = 0; j < 4; ++j) vtd[(size_t)(cd + j) * T_TOK + row] = (hf)v[j]; }
    EPI_END } };
struct EpiUkv { hf* km; hf* vtm;
  DI void operator()(f4 (&acc)[4][4], int b, int row0, int col0, int fr, int fq) const {
    EPI_BEGIN
      int head = c / 192, d = c - head * 192;
      if (d < 64) *(h4*)(km + ((size_t)row * 8 + head) * 96 + d) = cvt4(v);
      else {
#pragma unroll
        for (int j = 0; j < 4; ++j) vtm[(size_t)(head * 128 + d - 64 + j) * T_TOK + row] = (hf)v[j]; }
    EPI_END } };

template <int RPL>
__device__ void rwkv_item(const Params& p, int seq, int head, int dir, int slab, char* smem) {
  float* sVec = (float*)smem;
  float* sV = sVec + 32 * 5 * 64;
  hf* sTw = (hf*)(sV + 32 * 64);
  hf* sDa = sTw + 32 * 72;
  float* sBon = (float*)(sDa + 32 * 72);
  const int tid = threadIdx.x, lane = tid & 63, wv = tid >> 6, fr = lane & 15, fq = lane >> 4;
  const int L = seq_len(seq), s0 = seq_start(seq);
  const hf* P = (const hf*)(p.ws + OFF_RB);
  hf* yout = (hf*)(p.ws + OFF_RA) + (size_t)dir * T_TOK * 1024;
  float* bonus = (float*)(p.ws + OFF_SMALL + SM_BONUS);
  const float* mu = p.in[10];
  const int chg = head * 64 + wv * 16 + fr;
  h8 wf[2], af2[2];
#pragma unroll
  for (int ks = 0; ks < 2; ++ks)
#pragma unroll
    for (int e = 0; e < 8; ++e) {
      int r = ks * 32 + fq * 8 + e;
      wf[ks][e] = (hf)p.in[12][(size_t)(dir * 64 + r) * 1024 + chg];
      af2[ks][e] = (hf)p.in[14][(size_t)(dir * 64 + r) * 1024 + chg];
    }
  const float c_w0 = p.in[11][dir * 1024 + chg], c_a0 = p.in[13][dir * 1024 + chg], c_ka = p.in[17][chg], c_rk = p.in[18][chg];
  const int li_t = tid >> 3, part = tid & 7;
  int gcol[5] = {head * 64 + part * 8, 1024 + head * 64 + part * 8, 2048 + head * 64 + part * 8, 3072 + dir * 64 + part * 8, 3200 + dir * 64 + part * 8};
  u4 raw[5][3];
  const int nch = L >> 5;
  auto load_raw = [&](int c) {
    int t0 = dir ? L - 32 * (c + 1) : 32 * c; int tl = t0 + li_t;
#pragma unroll
    for (int g = 0; g < 5; ++g)
#pragma unroll
      for (int n = 0; n < 3; ++n) {
        int tt = tl + n - 1;
        raw[g][n] = (tt >= 0 && tt < L) ? *(const u4*)(P + (size_t)(s0 + tt) * 3456 + gcol[g]) : (u4){0u, 0u, 0u, 0u};
      }
  };
  float S[RPL][4];
#pragma unroll
  for (int r = 0; r < RPL; ++r) { S[r][0] = 0.f; S[r][1] = 0.f; S[r][2] = 0.f; S[r][3] = 0.f; }
  const int ks_ = tid & 15, rg = tid >> 4, rbase = slab * (16 * RPL) + rg * RPL;
  load_raw(0);
  for (int c = 0; c < nch; ++c) {
    const int t0 = dir ? L - 32 * (c + 1) : 32 * c;
    __syncthreads();
#pragma unroll
    for (int g = 0; g < 5; ++g) {
      h8 pv = __builtin_bit_cast(h8, raw[g][0]), cv = __builtin_bit_cast(h8, raw[g][1]), nv = __builtin_bit_cast(h8, raw[g][2]);
      float mx[8];
      const float4 m0 = *(const float4*)(mu + gcol[g]), m1 = *(const float4*)(mu + gcol[g] + 4);
      const float mm[8] = {m0.x, m0.y, m0.z, m0.w, m1.x, m1.y, m1.z, m1.w};
#pragma unroll
      for (int e = 0; e < 8; ++e) { float cu = (float)cv[e]; mx[e] = cu + mm[e] * (0.5f * ((float)pv[e] + (float)nv[e]) - cu); }
      if (g == 0) {
#pragma unroll
        for (int e = 0; e < 8; ++e) sVec[(li_t * 5 + 4) * 64 + part * 8 + e] = mx[e];
      } else if (g == 1) {
        const float4 k0 = *(const float4*)(p.in[16] + head * 64 + part * 8), k1 = *(const float4*)(p.in[16] + head * 64 + part * 8 + 4);
        const float kkc[8] = {k0.x, k0.y, k0.z, k0.w, k1.x, k1.y, k1.z, k1.w};
        float kkv[8], ss = 0.f;
#pragma unroll
        for (int e = 0; e < 8; ++e) { kkv[e] = mx[e] * kkc[e]; ss += kkv[e] * kkv[e]; sVec[(li_t * 5 + 3) * 64 + part * 8 + e] = mx[e]; }
        ss += __shfl_xor(ss, 1); ss += __shfl_xor(ss, 2); ss += __shfl_xor(ss, 4);
        float inv = 1.f / fmaxf(sqrtf(ss), 1e-12f);
#pragma unroll
        for (int e = 0; e < 8; ++e) sVec[(li_t * 5 + 1) * 64 + part * 8 + e] = kkv[e] * inv;
      } else if (g == 2) {
#pragma unroll
        for (int e = 0; e < 8; ++e) sV[li_t * 64 + part * 8 + e] = mx[e];
      } else if (g == 3) {
#pragma unroll
        for (int e = 0; e < 8; ++e) sTw[li_t * 72 + part * 8 + e] = (hf)(1.f - 2.f / (1.f + __expf(2.f * mx[e])));
      } else {
#pragma unroll
        for (int e = 0; e < 8; ++e) sDa[li_t * 72 + part * 8 + e] = (hf)mx[e];
      }
    }
    if (tid < 32) sBon[tid] = 0.f;
    __syncthreads();
    if (c + 1 < nch) load_raw(c + 1);
#pragma unroll
    for (int mt = 0; mt < 2; ++mt) {
      f4 accw = {0.f, 0.f, 0.f, 0.f}, acca = {0.f, 0.f, 0.f, 0.f};
#pragma unroll
      for (int ks = 0; ks < 2; ++ks) {
        h8 a1 = *(const h8*)(sTw + (mt * 16 + fr) * 72 + ks * 32 + fq * 8);
        h8 a2 = *(const h8*)(sDa + (mt * 16 + fr) * 72 + ks * 32 + fq * 8);
        accw = mfma16(a1, wf[ks], accw); acca = mfma16(a2, af2[ks], acca);
      }
      const int ch = wv * 16 + fr;
#pragma unroll
      for (int j = 0; j < 4; ++j) {
        int l2 = mt * 16 + fq * 4 + j;
        float dec = __expf(-0.6065306597f * sigmoidf_(c_w0 + accw[j]));
        float icl = sigmoidf_(c_a0 + acca[j]);
        float kx = sVec[(l2 * 5 + 3) * 64 + ch], kkv = sVec[(l2 * 5 + 1) * 64 + ch], rr = sVec[(l2 * 5 + 4) * 64 + ch];
        float kd = kx * (1.f + (icl - 1.f) * c_ka);
        sVec[(l2 * 5 + 0) * 64 + ch] = dec; sVec[(l2 * 5 + 2) * 64 + ch] = icl * kkv; sVec[(l2 * 5 + 3) * 64 + ch] = kd;
        float bon = rr * kd * c_rk;
        bon += __shfl_xor(bon, 1); bon += __shfl_xor(bon, 2); bon += __shfl_xor(bon, 4); bon += __shfl_xor(bon, 8);
        if (fr == 0) atomicAdd(&sBon[l2], bon);
      }
    }
    __syncthreads();
    if (slab == 0 && tid < 32) bonus[((size_t)(s0 + t0 + tid) * 16 + head) * 2 + dir] = sBon[tid];
#pragma unroll 4
    for (int i = 0; i < 32; ++i) {
      const int li = dir ? 31 - i : i;
      const float* base = sVec + li * 320 + ks_ * 4;
      const float4 w4 = *(const float4*)(base), kk4 = *(const float4*)(base + 64), b4 = *(const float4*)(base + 128),
                   kd4 = *(const float4*)(base + 192), r4 = *(const float4*)(base + 256);
#pragma unroll
      for (int r = 0; r < RPL; ++r) {
        const float vv = sV[li * 64 + rbase + r];
        float sa = S[r][0] * kk4.x + S[r][1] * kk4.y + S[r][2] * kk4.z + S[r][3] * kk4.w;
        sa = allred16(sa);
        S[r][0] = S[r][0] * w4.x - sa * b4.x + vv * kd4.x;
        S[r][1] = S[r][1] * w4.y - sa * b4.y + vv * kd4.y;
        S[r][2] = S[r][2] * w4.z - sa * b4.z + vv * kd4.z;
        S[r][3] = S[r][3] * w4.w - sa * b4.w + vv * kd4.w;
        float y = S[r][0] * r4.x + S[r][1] * r4.y + S[r][2] * r4.z + S[r][3] * r4.w;
        y = allred16(y);
        if (ks_ == 0) yout[(size_t)(s0 + t0 + li) * 1024 + head * 64 + rbase + r] = (hf)y;
      }
    }
  }
}

__device__ void rwkv_scan_phase(const Params& p, char* smem) {
  for (int item = blockIdx.x; item < 384; item += gridDim.x) {
    if (item < 128) rwkv_item<1>(p, 4, item >> 3, (item >> 2) & 1, item & 3, smem);
    else { int it = item - 128; rwkv_item<2>(p, it >> 6, (it >> 2) & 15, (it >> 1) & 1, it & 1, smem); }
  }
}

__device__ void gate_prep(const Params& p) {
  const hf* P = (const hf*)(p.ws + OFF_RB);
  hf* sg = (hf*)(p.ws + OFF_US5 + 96 * MiB);
  const float* mu = p.in[10];
  for (int idx = blockIdx.x * 256 + threadIdx.x; idx < T_TOK * 16; idx += gridDim.x * 256) {
    int t = idx >> 4, part = idx & 15, col = 3328 + part * 8;
    int sq = seq_of(t), pos = t - seq_start(sq), L = seq_len(sq);
    h8 cv = *(const h8*)(P + (size_t)t * 3456 + col), pv, nv;
    for (int e = 0; e < 8; ++e) { pv[e] = (hf)0; nv[e] = (hf)0; }
    if (pos > 0) pv = *(const h8*)(P + (size_t)(t - 1) * 3456 + col);
    if (pos < L - 1) nv = *(const h8*)(P + (size_t)(t + 1) * 3456 + col);
    h8 o;
#pragma unroll
    for (int e = 0; e < 8; ++e) { float cu = (float)cv[e]; float mx = cu + mu[col + e] * (0.5f * ((float)pv[e] + (float)nv[e]) - cu); o[e] = (hf)sigmoidf_(mx); }
    *(h8*)(sg + (size_t)t * 128 + part * 8) = o;
  }
}

__device__ void rwkv_post(const Params& p) {
  const hf* P = (const hf*)(p.ws + OFF_RB);
  const hf* y0 = (const hf*)(p.ws + OFF_RA); const hf* y1 = y0 + (size_t)T_TOK * 1024;
  const hf* g16 = (const hf*)(p.ws + OFF_US5);
  const float* bonus = (const float*)(p.ws + OFF_SMALL + SM_BONUS);
  hf* mix = (hf*)(p.ws + OFF_MIX0);
  const float* mu = p.in[10];
  const int lane = threadIdx.x & 63, gw = blockIdx.x * 4 + (threadIdx.x >> 6), nw = gridDim.x * 4;
  for (int t = gw; t < T_TOK; t += nw) {
    int sq = seq_of(t), pos = t - seq_start(sq), L = seq_len(sq);
    int ch0 = lane * 16, head = lane >> 2;
    float y[16]; float sum = 0.f;
#pragma unroll
    for (int q = 0; q < 2; ++q) {
      h8 a = *(const h8*)(y0 + (size_t)t * 1024 + ch0 + q * 8), bq = *(const h8*)(y1 + (size_t)t * 1024 + ch0 + q * 8);
#pragma unroll
      for (int e = 0; e < 8; ++e) { y[q * 8 + e] = (float)a[e] + (float)bq[e]; sum += y[q * 8 + e]; }
    }
    sum += __shfl_xor(sum, 1); sum += __shfl_xor(sum, 2);
    float mean = sum * (1.f / 64.f), var = 0.f;
#pragma unroll
    for (int e = 0; e < 16; ++e) { float dd = y[e] - mean; var += dd * dd; }
    var += __shfl_xor(var, 1); var += __shfl_xor(var, 2);
    float rs = rsqrtf(var * (1.f / 64.f) + 64e-5f);
    float bon = bonus[((size_t)t * 16 + head) * 2] + bonus[((size_t)t * 16 + head) * 2 + 1];
#pragma unroll
    for (int q = 0; q < 2; ++q) {
      int col = 2048 + ch0 + q * 8;
      h8 cv = *(const h8*)(P + (size_t)t * 3456 + col), pv, nv;
      for (int e = 0; e < 8; ++e) { pv[e] = (hf)0; nv[e] = (hf)0; }
      if (pos > 0) pv = *(const h8*)(P + (size_t)(t - 1) * 3456 + col);
      if (pos < L - 1) nv = *(const h8*)(P + (size_t)(t + 1) * 3456 + col);
      h8 gg = *(const h8*)(g16 + (size_t)t * 1024 + ch0 + q * 8), o;
#pragma unroll
      for (int e = 0; e < 8; ++e) {
        int ch = ch0 + q * 8 + e;
        float cu = (float)cv[e]; float vm = cu + mu[col + e] * (0.5f * ((float)pv[e] + (float)nv[e]) - cu);
        float yn = (y[q * 8 + e] - mean) * rs * p.in[19][ch] + p.in[20][ch] + bon * vm;
        o[e] = (hf)(yn * (float)gg[e]);
      }
      *(h8*)(mix + (size_t)t * 2048 + ch0 + q * 8) = o;
    }
  }
}

__device__ void convact_phase(const Params& p, int layer, int slab) {
  const hf* U = (const hf*)(p.ws + OFF_RB); hf* act = (hf*)(p.ws + OFF_ACT);
  const float* cw = p.in[44] + (size_t)layer * 3 * 11264; const float* cb = p.in[45] + (size_t)layer * 11264;
  const int lmask = slab == 2 ? 16383 : 8191;
  for (int idx = blockIdx.x * 256 + threadIdx.x; idx < 16384 * 704; idx += gridDim.x * 256) {
    int row = idx / 704, f0 = (idx - row * 704) * 8, pos = row & lmask;
    bool hp = pos > 0, hn = pos < lmask;
    float res[2][8];
#pragma unroll
    for (int hh = 0; hh < 2; ++hh) {
      int col = f0 + hh * 5632;
      h8 cv = *(const h8*)(U + (size_t)row * 11264 + col), pv, nv;
      for (int e = 0; e < 8; ++e) { pv[e] = (hf)0; nv[e] = (hf)0; }
      if (hp) pv = *(const h8*)(U + (size_t)(row - 1) * 11264 + col);
      if (hn) nv = *(const h8*)(U + (size_t)(row + 1) * 11264 + col);
#pragma unroll
      for (int e = 0; e < 8; ++e)
        res[hh][e] = (float)pv[e] * cw[col + e] + (float)cv[e] * cw[11264 + col + e] + (float)nv[e] * cw[22528 + col + e] + cb[col + e];
    }
    h8 o;
#pragma unroll
    for (int e = 0; e < 8; ++e) { float gt = res[1][e]; o[e] = (hf)(gt * sigmoidf_(gt) * res[0][e]); }
    *(h8*)(act + (size_t)row * 5632 + f0) = o;
  }
}

__device__ void mla_prep(const Params& p) {
  const hf* p1 = (const hf*)(p.ws + OFF_RB);
  hf* cqn = (hf*)(p.ws + OFF_MIX1); hf* ckvn = (hf*)(p.ws + OFF_MIX1 + 48 * MiB);
  hf* km = (hf*)(p.ws + OFF_RA + 72 * MiB);
  const int lane = threadIdx.x & 63, gw = blockIdx.x * 4 + (threadIdx.x >> 6), nw = gridDim.x * 4;
  if (blockIdx.x == 0 && threadIdx.x == 0) {
    float s1 = 0.f, s2 = 0.f;
    for (int i = 0; i < 64; ++i) { s1 += p.in[37][i] * p.in[38][i]; s2 += p.in[39][i] * p.in[40][i]; }
    float* lamp = (float*)(p.ws + OFF_SMALL + SM_CNT) + 8;
    lamp[0] = __expf(s1) - __expf(s2) + 0.35550906759f;
  }
  for (int t = gw; t < T_TOK; t += nw) {
    const hf* row = p1 + (size_t)t * 2848;
    h8 a = *(const h8*)(row + lane * 8); float ss = 0.f;
#pragma unroll
    for (int e = 0; e < 8; ++e) ss += (float)a[e] * (float)a[e];
#pragma unroll
    for (int o = 32; o; o >>= 1) ss += __shfl_xor(ss, o);
    float r = rsqrtf(ss * (1.f / 512.f) + 1e-6f); h8 o8;
#pragma unroll
    for (int e = 0; e < 8; ++e) o8[e] = (hf)((float)a[e] * r * p.in[33][lane * 8 + e]);
    *(h8*)(cqn + (size_t)t * 512 + lane * 8) = o8;
    h4 b4 = *(const h4*)(row + 512 + lane * 4); float s2 = 0.f;
#pragma unroll
    for (int e = 0; e < 4; ++e) s2 += (float)b4[e] * (float)b4[e];
#pragma unroll
    for (int o = 32; o; o >>= 1) s2 += __shfl_xor(s2, o);
    float r2 = rsqrtf(s2 * (1.f / 256.f) + 1e-6f); h4 o4;
#pragma unroll
    for (int e = 0; e < 4; ++e) o4[e] = (hf)((float)b4[e] * r2 * p.in[34][lane * 4 + e]);
    *(h4*)(ckvn + (size_t)t * 256 + lane * 4) = o4;
    if (lane < 16) {
      int pos = t - seq_start(seq_of(t));
      float inv = exp2f(-(float)lane * 0.830482023721841f);
      float sn, cs; sincos_red((float)pos * inv, sn, cs);
      float x1 = (float)row[768 + lane], x2 = (float)row[784 + lane];
      hf o1 = (hf)(x1 * cs - x2 * sn), o2 = (hf)(x1 * sn + x2 * cs);
#pragma unroll
      for (int h = 0; h < 8; ++h) { km[((size_t)t * 8 + h) * 96 + 64 + lane] = o1; km[((size_t)t * 8 + h) * 96 + 80 + lane] = o2; }
    }
  }
}

__device__ void q_rope(const Params& p) {
  hf* qm = (hf*)(p.ws + OFF_RA);
  for (int idx = blockIdx.x * 256 + threadIdx.x; idx < T_TOK * 128; idx += gridDim.x * 256) {
    int t = idx >> 7, h = (idx >> 4) & 7, i = idx & 15;
    int pos = t - seq_start(seq_of(t));
    float inv = exp2f(-(float)i * 0.830482023721841f);
    float sn, cs; sincos_red((float)pos * inv, sn, cs);
    hf* a = qm + ((size_t)t * 8 + h) * 96 + 64 + i;
    float x1 = (float)a[0], x2 = (float)a[16];
    a[0] = (hf)(x1 * cs - x2 * sn); a[16] = (hf)(x1 * sn + x2 * cs);
  }
}

template <int DQK, bool BIAS>
__device__ __forceinline__ void attn_pass(const hf* __restrict__ Q, int ldq, const hf* __restrict__ Kp, int ldk, const hf* __restrict__ VT,
                                          int s0, int L, int q0, float scale_l2, const float* sBias, f4 (&oacc)[8][2], char* smem) {
  constexpr int KS = DQK + 8, NKS = DQK / 32, KCH = DQK / 8, NKL = 64 * KCH / 256;
  hf* sK = (hf*)smem; hf* sVT = (hf*)(smem + 13312);
  const int tid = threadIdx.x, lane = tid & 63, wv = tid >> 6, fr = lane & 15, fq = lane >> 4;
  h8 qf[2][NKS];
#pragma unroll
  for (int nq = 0; nq < 2; ++nq)
#pragma unroll
    for (int ks = 0; ks < NKS; ++ks) qf[nq][ks] = *(const h8*)(Q + (size_t)(s0 + q0 + wv * 32 + nq * 16 + fr) * ldq + ks * 32 + fq * 8);
  float mrun[2] = {-1e30f, -1e30f}, lrun[2] = {0.f, 0.f};
#pragma unroll
  for (int md = 0; md < 8; ++md) { oacc[md][0] = (f4){0.f, 0.f, 0.f, 0.f}; oacc[md][1] = (f4){0.f, 0.f, 0.f, 0.f}; }
  u4 rk[NKL], rv[4];
  auto loadKV = [&](int kt) {
    const int key0 = kt * 64;
#pragma unroll
    for (int i = 0; i < NKL; ++i) { int idx = tid + 256 * i, row = idx / KCH, ch = idx - row * KCH; rk[i] = *(const u4*)(Kp + (size_t)(s0 + key0 + row) * ldk + ch * 8); }
#pragma unroll
    for (int i = 0; i < 4; ++i) { int idx = tid + 256 * i, dv = idx >> 3, ch = idx & 7; rv[i] = *(const u4*)(VT + (size_t)dv * T_TOK + s0 + key0 + ch * 8); }
  };
  const int nkt = L >> 6;
  for (int kt = 0; kt < nkt; ++kt) {
    loadKV(kt);
    __syncthreads();
#pragma unroll
    for (int i = 0; i < NKL; ++i) { int idx = tid + 256 * i, row = idx / KCH, ch = idx - row * KCH; *(u4*)(sK + row * KS + ch * 8) = rk[i]; }
#pragma unroll
    for (int i = 0; i < 4; ++i) { int idx = tid + 256 * i, dv = idx >> 3, ch = idx & 7; *(u4*)(sVT + dv * 72 + ch * 8) = rv[i]; }
    __syncthreads();
    f4 sacc[4][2];
#pragma unroll
    for (int mk = 0; mk < 4; ++mk) { sacc[mk][0] = (f4){0.f, 0.f, 0.f, 0.f}; sacc[mk][1] = (f4){0.f, 0.f, 0.f, 0.f}; }
#pragma unroll
    for (int mk = 0; mk < 4; ++mk)
#pragma unroll
      for (int ks = 0; ks < NKS; ++ks) {
        h8 kf = *(const h8*)(sK + (mk * 16 + fr) * KS + ks * 32 + fq * 8);
        sacc[mk][0] = mfma16(kf, qf[0][ks], sacc[mk][0]); sacc[mk][1] = mfma16(kf, qf[1][ks], sacc[mk][1]);
        if (ks == NKS - 1 && (mk & 1)) __builtin_amdgcn_sched_barrier(0);
      }
    const int key0 = kt * 64;
    __builtin_amdgcn_sched_barrier(0);
    if (BIAS) {
      const int dmin = key0 - (q0 + 127), dmax = key0 + 63 - q0;
      if (dmax <= -91 || dmin >= 91) {
        const float add = dmax <= -91 ? sBias[0] : sBias[256];
#pragma unroll
        for (int mk = 0; mk < 4; ++mk)
#pragma unroll
          for (int nq = 0; nq < 2; ++nq)
#pragma unroll
            for (int j = 0; j < 4; ++j) sacc[mk][nq][j] = sacc[mk][nq][j] * scale_l2 + add;
      } else {
#pragma unroll
        for (int mk = 0; mk < 4; ++mk)
#pragma unroll
          for (int nq = 0; nq < 2; ++nq)
#pragma unroll
            for (int j = 0; j < 4; ++j) {
              int rel = (key0 + mk * 16 + fq * 4 + j) - (q0 + wv * 32 + nq * 16 + fr);
              rel = min(max(rel, -128), 128);
              sacc[mk][nq][j] = sacc[mk][nq][j] * scale_l2 + sBias[rel + 128];
            }
      }
    } else {
#pragma unroll
      for (int mk = 0; mk < 4; ++mk)
#pragma unroll
        for (int nq = 0; nq < 2; ++nq)
#pragma unroll
          for (int j = 0; j < 4; ++j) sacc[mk][nq][j] *= scale_l2;
    }
    __builtin_amdgcn_sched_barrier(0);
#pragma unroll
    for (int nq = 0; nq < 2; ++nq) {
      float mx = -1e30f;
#pragma unroll
      for (int mk = 0; mk < 4; ++mk)
#pragma unroll
        for (int j = 0; j < 4; ++j) mx = fmaxf(mx, sacc[mk][nq][j]);
      mx = fmaxf(mx, __shfl_xor(mx, 16)); mx = fmaxf(mx, __shfl_xor(mx, 32));
      const float mnew = fmaxf(mrun[nq], mx), alpha = __builtin_amdgcn_exp2f(mrun[nq] - mnew);
      mrun[nq] = mnew;
      float ps = 0.f;
#pragma unroll
      for (int mk = 0; mk < 4; ++mk)
#pragma unroll
        for (int j = 0; j < 4; ++j) { float pe = __builtin_amdgcn_exp2f(sacc[mk][nq][j] - mnew); sacc[mk][nq][j] = pe; ps += pe; }
      lrun[nq] = lrun[nq] * alpha + ps;
#pragma unroll
      for (int md = 0; md < 8; ++md) { oacc[md][nq][0] *= alpha; oacc[md][nq][1] *= alpha; oacc[md][nq][2] *= alpha; oacc[md][nq][3] *= alpha; }
      __builtin_amdgcn_sched_barrier(0);
    }
    h8 pf[2][2];
#pragma unroll
    for (int nq = 0; nq < 2; ++nq)
#pragma unroll
      for (int s2 = 0; s2 < 2; ++s2)
#pragma unroll
        for (int i = 0; i < 8; ++i) pf[nq][s2][i] = (hf)sacc[2 * s2 + (i >> 2)][nq][i & 3];
    __builtin_amdgcn_sched_barrier(0);
#pragma unroll
    for (int md = 0; md < 8; ++md)
#pragma unroll
      for (int s2 = 0; s2 < 2; ++s2) {
        h4 v0 = *(const h4*)(sVT + (md * 16 + fr) * 72 + s2 * 32 + fq * 4);
        h4 v1 = *(const h4*)(sVT + (md * 16 + fr) * 72 + s2 * 32 + 16 + fq * 4);
        h8 vf = __builtin_shufflevector(v0, v1, 0, 1, 2, 3, 4, 5, 6, 7);
        oacc[md][0] = mfma16(vf, pf[0][s2], oacc[md][0]); oacc[md][1] = mfma16(vf, pf[1][s2], oacc[md][1]);
        if (s2 == 1 && (md & 1)) __builtin_amdgcn_sched_barrier(0);
      }
  }
#pragma unroll
  for (int nq = 0; nq < 2; ++nq) {
    float lt = lrun[nq]; lt += __shfl_xor(lt, 16); lt += __shfl_xor(lt, 32);
    const float inv = 1.f / lt;
#pragma unroll
    for (int md = 0; md < 8; ++md) { oacc[md][nq][0] *= inv; oacc[md][nq][1] *= inv; oacc[md][nq][2] *= inv; oacc[md][nq][3] *= inv; }
  }
}

__device__ void attn_phase(const Params& p, char* smem) {
  __shared__ int sItem;
  int* counter = (int*)(p.ws + OFF_SMALL + SM_CNT);
  const float lam = ((const float*)(p.ws + OFF_SMALL + SM_CNT))[8];
  float* sBias = (float*)(smem + 13312 + 18432);
  const hf* p1 = (const hf*)(p.ws + OFF_RB);
  const hf* vtd = (const hf*)(p.ws + OFF_VTD); const hf* vtm = (const hf*)(p.ws + OFF_VTM);
  const hf* qm = (const hf*)(p.ws + OFF_RA); const hf* km = (const hf*)(p.ws + OFF_RA + 72 * MiB);
  hf* mix = (hf*)(p.ws + OFF_MIX1);
  const int tid = threadIdx.x, lane = tid & 63, wv = tid >> 6, fr = lane & 15, fq = lane >> 4;
  while (true) {
    __syncthreads();
    if (tid == 0) sItem = atomicAdd(counter, 1);
    __syncthreads();
    const int item = sItem;
    if (item >= 3072) break;
    int seq, h, qt;
    if (item < 1024) { seq = 4; h = item >> 7; qt = item & 127; }
    else { int it = item - 1024; seq = it >> 9; h = (it >> 6) & 7; qt = it & 63; }
    const int s0 = seq_start(seq), L = seq_len(seq), q0 = qt * 128;
    for (int i = tid; i < 257; i += 256) {
      int rel = i - 128, n = rel < 0 ? -rel : rel;
      int bk = n < 8 ? n : (n < 12 ? 8 : n < 16 ? 9 : n < 23 ? 10 : n < 32 ? 11 : n < 46 ? 12 : n < 64 ? 13 : n < 91 ? 14 : 15);
      if (rel > 0) bk += 16;
      sBias[i] = p.in[42][bk * 8 + h] * 1.44269504089f;
    }
#pragma unroll 1
    for (int m = 0; m < 2; ++m) {
      f4 oacc[8][2];
      attn_pass<64, true>(p1 + 800 + h * 128 + m * 64, 2848, p1 + 1824 + h * 128 + m * 64, 2848, vtd + (size_t)h * 128 * T_TOK, s0, L, q0,
                          0.125f * 1.44269504089f, sBias, oacc, smem);
      if (m == 0) {
#pragma unroll
        for (int nq = 0; nq < 2; ++nq)
#pragma unroll
          for (int md = 0; md < 8; ++md)
            *(h4*)(mix + (size_t)(s0 + q0 + wv * 32 + nq * 16 + fr) * 2048 + 1024 + h * 128 + md * 16 + fq * 4) = cvt4(oacc[md][nq]);
      } else {
#pragma unroll
        for (int nq = 0; nq < 2; ++nq) {
          hf* dst = mix + (size_t)(s0 + q0 + wv * 32 + nq * 16 + fr) * 2048 + 1024 + h * 128 + fq * 4;
          float ss = 0.f;
#pragma unroll
          for (int md = 0; md < 8; ++md) {
            h4 o0 = *(const h4*)(dst + md * 16);
#pragma unroll
            for (int j = 0; j < 4; ++j) { float o = (float)o0[j] - lam * oacc[md][nq][j]; oacc[md][nq][j] = o; ss += o * o; }
          }
          ss += __shfl_xor(ss, 16); ss += __shfl_xor(ss, 32);
          const float r = rsqrtf(ss * (1.f / 128.f) + 1e-5f) * (1.f - 0.35550906759f);
#pragma unroll
          for (int md = 0; md < 8; ++md) {
            f4 gg = *(const f4*)(p.in[41] + md * 16 + fq * 4); h4 o;
#pragma unroll
            for (int j = 0; j < 4; ++j) o[j] = (hf)(oacc[md][nq][j] * r * gg[j]);
            *(h4*)(dst + md * 16) = o;
          }
        }
      }
    }
  }
  while (true) {
    __syncthreads();
    if (tid == 0) sItem = atomicAdd(counter + 1, 1);
    __syncthreads();
    const int item = sItem;
    if (item >= 3072) break;
    int seq, h, qt;
    if (item < 1024) { seq = 4; h = item >> 7; qt = item & 127; }
    else { int it = item - 1024; seq = it >> 9; h = (it >> 6) & 7; qt = it & 63; }
    const int s0 = seq_start(seq), L = seq_len(seq), q0 = qt * 128;
    f4 oacc[8][2];
    attn_pass<96, false>(qm + h * 96, 768, km + h * 96, 768, vtm + (size_t)h * 128 * T_TOK, s0, L, q0, 0.10206207262f * 1.44269504089f, nullptr, oacc, smem);
#pragma unroll
    for (int nq = 0; nq < 2; ++nq)
#pragma unroll
      for (int md = 0; md < 8; ++md)
        *(h4*)(mix + (size_t)(s0 + q0 + wv * 32 + nq * 16 + fr) * 2048 + h * 128 + md * 16 + fq * 4) = cvt4(oacc[md][nq]);
  }
}

__device__ void ffn_layer(const Params& p, cg::grid_group& grid, int layer, char* smem) {
  const hf* W = (const hf*)(p.ws + OFF_W);
  const hf* wup = W + (layer == 0 ? W0_FUP : W1_FUP); const hf* wdn = W + (layer == 0 ? W0_FDN : W1_FDN);
  const hf* h16 = (const hf*)(p.ws + OFF_RA);
  hf* u16 = (hf*)(p.ws + OFF_RB); hf* act = (hf*)(p.ws + OFF_ACT);
  const float* mod = (const float*)(p.ws + OFF_SMALL + SM_MOD) + (size_t)layer * 5 * 12288;
  for (int slab = 0; slab < 3; ++slab) {
    gemm_run(GemmArgs{h16 + (size_t)slab * 16384 * 2048, 2048, 0, wup, 2048, 0, 16384, 11264, 2048, 1}, EpiStore{u16, 11264}, smem);
    grid.sync();
    convact_phase(p, layer, slab);
    grid.sync();
    gemm_run(GemmArgs{act, 5632, 0, wdn, 5632, 0, 16384, 2048, 5632, 1}, EpiResid{p.out, mod + 5 * 2048, slab * 16384}, smem);
    grid.sync();
  }
}

__global__ void __launch_bounds__(256, 1) mega(Params p) {
  cg::grid_group grid = cg::this_grid();
  __shared__ __attribute__((aligned(16))) char smem[59392];
  hf* W = (hf*)(p.ws + OFF_W);
  float* mod = (float*)(p.ws + OFF_SMALL + SM_MOD);
  if (p.stop <= 0) { final_norm(p); return; }
  if (blockIdx.x == 0 && threadIdx.x == 0) { int* cnt = (int*)(p.ws + OFF_SMALL + SM_CNT); cnt[0] = 0; cnt[1] = 0; }
  adaln_phase(p, smem);
  s5_tabA(p, smem);
  cvt_t(p.in[8], W + W0_IN, 2048, 4480, smem);
  cvt_t(p.in[9], W + W0_OUT, 2048, 2048, smem);
  cvt_t(p.in[29], W + W0_GLU, 1024, 1024, smem);
  cvt_t(p.in[15], W + W0_GUP, 128, 1024, smem);
  cvt_t(p.in[43], W + W0_FUP, 2048, 11264, smem);
  cvt_t(p.in[46], W + W0_FDN, 5632, 2048, smem);
  grid.sync(); if (p.stop <= 1) { final_norm(p); return; }
  norm_phase(p, 0, 0, true);
  s5_tabB(p);
  grid.sync(); if (p.stop <= 2) { final_norm(p); return; }
  gemm_run(GemmArgs{(const hf*)(p.ws + OFF_RA), 2048, 0, W + W0_IN, 2048, 0, T_TOK, 4480, 2048, 1},
           EpiInproj0{(hf*)(p.ws + OFF_RB), (hf*)(p.ws + OFF_US5)}, smem);
  grid.sync(); if (p.stop <= 3) { final_norm(p); return; }
  gemm_run(GemmArgs{(const hf*)(p.ws + OFF_US5), 768, (size_t)1536 * 768, (const hf*)(p.ws + OFF_S5M), 512, (size_t)256 * 512, 1536, 256, 512, 64},
           EpiS5p1{(float*)(p.ws + OFF_RA)}, smem);
  grid.sync(); if (p.stop <= 4) { final_norm(p); return; }
  s5_carry(p);
  grid.sync(); if (p.stop <= 5) { final_norm(p); return; }
  gemm_run(GemmArgs{(const hf*)(p.ws + OFF_US5), 768, (size_t)1536 * 768, (const hf*)(p.ws + OFF_S5M + 16 * MiB), 768, (size_t)512 * 768, 1536, 512, 768, 64},
           EpiS5p2{(hf*)(p.ws + OFF_RA + 96 * MiB)}, smem);
  grid.sync(); if (p.stop <= 6) { final_norm(p); return; }
  gemm_run(GemmArgs{(const hf*)(p.ws + OFF_RA + 96 * MiB), 1024, 0, W + W0_GLU, 1024, 0, T_TOK, 1024, 1024, 1},
           EpiGlu{(const hf*)(p.ws + OFF_RA + 96 * MiB), p.in[30], (hf*)(p.ws + OFF_MIX0)}, smem);
  gate_prep(p);
  grid.sync(); if (p.stop <= 7) { final_norm(p); return; }
  gemm_run(GemmArgs{(const hf*)(p.ws + OFF_US5 + 96 * MiB), 128, 0, W + W0_GUP, 128, 0, T_TOK, 1024, 128, 1},
           EpiStore{(hf*)(p.ws + OFF_US5), 1024}, smem);
  rwkv_scan_phase(p, smem);
  grid.sync(); if (p.stop <= 8) { final_norm(p); return; }
  rwkv_post(p);
  grid.sync(); if (p.stop <= 9) { final_norm(p); return; }
  gemm_run(GemmArgs{(const hf*)(p.ws + OFF_MIX0), 2048, 0, W + W0_OUT, 2048, 0, T_TOK, 2048, 2048, 1},
           EpiResid{p.out, mod + 2 * 2048, 0}, smem);
  grid.sync(); if (p.stop <= 10) { final_norm(p); return; }
  norm_phase(p, 0, 1, false);
  grid.sync(); if (p.stop <= 11) { final_norm(p); return; }
  ffn_layer(p, grid, 0, smem);
  cvt_t(p.in[31], W + W1_IN, 2048, 3872, smem);
  cvt_t(p.in[32], W + W1_OUT, 2048, 2048, smem);
  cvt_t(p.in[35], W + W1_UQ, 512, 768, smem);
  cvt_t(p.in[36], W + W1_UKV, 256, 1536, smem);
  cvt_t(p.in[43] + (size_t)2048 * 11264, W + W1_FUP, 2048, 11264, smem);
  cvt_t(p.in[46] + (size_t)5632 * 2048, W + W1_FDN, 5632, 2048, smem);
  norm_phase(p, 1, 0, false);
  grid.sync(); if (p.stop <= 12) { final_norm(p); return; }
  gemm_run(GemmArgs{(const hf*)(p.ws + OFF_RA), 2048, 0, W + W1_IN, 2048, 0, T_TOK, 3872, 2048, 1},
           EpiInproj1{(hf*)(p.ws + OFF_RB), (hf*)(p.ws + OFF_VTD)}, smem);
  grid.sync(); if (p.stop <= 13) { final_norm(p); return; }
  mla_prep(p);
  grid.sync(); if (p.stop <= 14) { final_norm(p); return; }
  gemm_run(GemmArgs{(const hf*)(p.ws + OFF_MIX1), 512, 0, W + W1_UQ, 512, 0, T_TOK, 768, 512, 1},
           EpiStore{(hf*)(p.ws + OFF_RA), 768}, smem);
  gemm_run(GemmArgs{(const hf*)(p.ws + OFF_MIX1 + 48 * MiB), 256, 0, W + W1_UKV, 256, 0, T_TOK, 1536, 256, 1},
           EpiUkv{(hf*)(p.ws + OFF_RA + 72 * MiB), (hf*)(p.ws + OFF_VTM)}, smem);
  grid.sync(); if (p.stop <= 15) { final_norm(p); return; }
  q_rope(p);
  grid.sync(); if (p.stop <= 16) { final_norm(p); return; }
  attn_phase(p, smem);
  grid.sync(); if (p.stop <= 17) { final_norm(p); return; }
  gemm_run(GemmArgs{(const hf*)(p.ws + OFF_MIX1), 2048, 0, W + W1_OUT, 2048, 0, T_TOK, 2048, 2048, 1},
           EpiResid{p.out, mod + (size_t)5 * 12288 + 2 * 2048, 0}, smem);
  grid.sync(); if (p.stop <= 18) { final_norm(p); return; }
  norm_phase(p, 1, 1, false);
  grid.sync(); if (p.stop <= 19) { final_norm(p); return; }
  ffn_layer(p, grid, 1, smem);
  final_norm(p);
}

extern "C" void kernel_launch(void* const* d_in, const int* in_sizes, int n_in, void* d_out, int out_size,
                              void* d_ws, size_t ws_size, hipStream_t stream) {
  static int grid_blocks = 0;
  if (!grid_blocks) {
    int dev = 0, cus = 0, per_cu = 0;
    (void)hipGetDevice(&dev);
    (void)hipDeviceGetAttribute(&cus, hipDeviceAttributeMultiprocessorCount, dev);
    (void)hipOccupancyMaxActiveBlocksPerMultiprocessor(&per_cu, mega, 256, 0);
    if (per_cu > 2) per_cu = 2;
    if (per_cu < 1) per_cu = 1;
    grid_blocks = cus * per_cu;
  }
  Params p{};
  for (int i = 0; i < 48; ++i) p.in[i] = (const float*)d_in[i];
  p.out = (float*)d_out; p.ws = (char*)d_ws; p.stop = STOP_AT;
  void* args[] = {&p};
  hipError_t e = hipLaunchCooperativeKernel((void*)mega, dim3(grid_blocks), dim3(256), args, 0, stream);
  if (e != hipSuccess) fprintf(stderr, "cooperative launch failed: %s (grid %d)\n", hipGetErrorString(e), grid_blocks);
}
```

```cpp
#include <hip/hip_runtime.h>
#include <hip/hip_cooperative_groups.h>
#include <cstdio>
#include <cstdint>
namespace cg = cooperative_groups;
typedef _Float16 hf;
using h8 = __attribute__((ext_vector_type(8))) _Float16;
using h4 = __attribute__((ext_vector_type(4))) _Float16;
using f4 = __attribute__((ext_vector_type(4))) float;
using u4 = __attribute__((ext_vector_type(4))) unsigned;

#define T_TOK 49152
#ifndef STOP_AT
#define STOP_AT 100
#endif
#define DI __device__ __forceinline__
constexpr size_t MiB = 1ull << 20;

struct Params {
  const float* in[48];
  float* out;
  char* ws;
  long stop;
};

constexpr size_t OFF_W = 0;
constexpr size_t OFF_RA = 96 * MiB;
constexpr size_t OFF_RB = 288 * MiB;
constexpr size_t OFF_US5 = 612 * MiB;
constexpr size_t OFF_MIX0 = 756 * MiB;
constexpr size_t OFF_S5M = 948 * MiB;
constexpr size_t OFF_SMALL = 1012 * MiB;
constexpr size_t OFF_ACT = 640 * MiB;
constexpr size_t OFF_VTD = 555 * MiB;
constexpr size_t OFF_VTM = 651 * MiB;
constexpr size_t OFF_MIX1 = 747 * MiB;
constexpr size_t SM_MOD = 0;
constexpr size_t SM_CNT = 512 * 1024;
constexpr size_t SM_KTAB = 1 * MiB;
constexpr size_t SM_BONUS = 5 * MiB;
constexpr size_t W0_IN = 0, W0_OUT = 9175040, W0_GLU = 13369344, W0_GUP = 14417920, W0_FUP = 14548992, W0_FDN = 37617664;
constexpr size_t W1_IN = 0, W1_OUT = 7929856, W1_UQ = 12124160, W1_UKV = 12517376, W1_FUP = 12910592, W1_FDN = 35979264;

DI int tidx() { int t = __builtin_amdgcn_workitem_id_x(); asm volatile("" : "+v"(t)); return t; }
DI int seq_of(int t) { return t < 32768 ? (t >> 13) : 4; }
DI int seq_start(int s) { return s < 4 ? s * 8192 : 32768; }
DI int seq_len(int s) { return s < 4 ? 8192 : 16384; }
DI float sigmoidf_(float x) { return 1.f / (1.f + __expf(-x)); }
DI h4 cvt4(f4 v) { h4 r; r[0] = (hf)v[0]; r[1] = (hf)v[1]; r[2] = (hf)v[2]; r[3] = (hf)v[3]; return r; }
DI void sincos_red(float x, float& s, float& c) {
  double a = (double)x; double n = rint(a * 0.15915494309189535); float r = (float)(a - n * 6.283185307179586);
  s = __sinf(r); c = __cosf(r);
}
DI float allred16(float x) {
  x += __builtin_bit_cast(float, __builtin_amdgcn_update_dpp(0, __builtin_bit_cast(int, x), 0x128, 0xf, 0xf, false));
  x += __builtin_bit_cast(float, __builtin_amdgcn_update_dpp(0, __builtin_bit_cast(int, x), 0x124, 0xf, 0xf, false));
  x += __builtin_bit_cast(float, __builtin_amdgcn_update_dpp(0, __builtin_bit_cast(int, x), 0x122, 0xf, 0xf, false));
  x += __builtin_bit_cast(float, __builtin_amdgcn_update_dpp(0, __builtin_bit_cast(int, x), 0x121, 0xf, 0xf, false));
  return x;
}
DI f4 mfma16(h8 a, h8 b, f4 c) { return __builtin_amdgcn_mfma_f32_16x16x32_f16(a, b, c, 0, 0, 0); }

__device__ __forceinline__ void cvt_t(const float* __restrict__ src, hf* __restrict__ dst, int K, int N, char* smem) {
  float* tile = (float*)smem;
  const int tk = K >> 6, tn = N >> 5, total = tk * tn, tid = tidx();
  for (int t = blockIdx.x; t < total; t += gridDim.x) {
    int kt = t / tn, nt = t - kt * tn;
    __syncthreads();
    int n = tid & 31, kr = tid >> 5;
#pragma unroll
    for (int i = 0; i < 8; ++i) tile[(kr + 8 * i) * 33 + n] = src[(size_t)(kt * 64 + kr + 8 * i) * N + nt * 32 + n];
    __syncthreads();
    int on = tid >> 3, ok = (tid & 7) * 8;
    h8 o;
#pragma unroll
    for (int e = 0; e < 8; ++e) o[e] = (hf)tile[(ok + e) * 33 + on];
    *(h8*)(dst + (size_t)(nt * 32 + on) * K + kt * 64 + ok) = o;
  }
}

__device__ __forceinline__ void adaln_phase(const Params& p, char* smem) {
  float* scs = (float*)smem;
  float* red = scs + 5 * 2048;
  float* mod = (float*)(p.ws + OFF_SMALL + SM_MOD);
  const int tid = tidx();
  __syncthreads();
  for (int i = tid; i < 5 * 2048; i += 256) {
    int s = i >> 11, k = i & 2047;
    float c = s < 4 ? p.in[2][s * 2048 + k] : p.in[3][k];
    scs[i] = c / (1.f + __expf(-c));
  }
  __syncthreads();
  for (int item = blockIdx.x; item < 384; item += gridDim.x) {
    int layer = item / 192, cb = item % 192, cl = tid & 63, kp = tid >> 6, col = cb * 64 + cl;
    const float* w = p.in[4] + (size_t)layer * 2048 * 12288 + col;
    float a0 = 0, a1 = 0, a2 = 0, a3 = 0, a4 = 0;
#pragma unroll 8
    for (int k = kp * 512; k < kp * 512 + 512; ++k) {
      float wv = w[(size_t)k * 12288];
      a0 += scs[k] * wv; a1 += scs[2048 + k] * wv; a2 += scs[4096 + k] * wv; a3 += scs[6144 + k] * wv; a4 += scs[8192 + k] * wv;
    }
    red[(kp * 5 + 0) * 64 + cl] = a0; red[(kp * 5 + 1) * 64 + cl] = a1; red[(kp * 5 + 2) * 64 + cl] = a2;
    red[(kp * 5 + 3) * 64 + cl] = a3; red[(kp * 5 + 4) * 64 + cl] = a4;
    __syncthreads();
    if (kp == 0) {
      float bb = p.in[5][layer * 12288 + col];
#pragma unroll
      for (int s = 0; s < 5; ++s)
        mod[(size_t)(layer * 5 + s) * 12288 + col] = red[s * 64 + cl] + red[(5 + s) * 64 + cl] + red[(10 + s) * 64 + cl] + red[(15 + s) * 64 + cl] + bb;
    }
    __syncthreads();
  }
}

__device__ __forceinline__ void s5_tabA(const Params& p, char* smem) {
  float* apow = (float*)smem;
  float* BB = apow + 33 * 128;
  float* CC = BB + 2048;
  float* sF = CC + 2048;
  float* Ktab = (float*)(p.ws + OFF_SMALL + SM_KTAB);
  hf* Bt1 = (hf*)(p.ws + OFF_S5M);
  hf* Bt2 = (hf*)(p.ws + OFF_S5M + 16 * MiB);
  const int tid = tidx();
  for (int item = blockIdx.x; item < 128; item += gridDim.x) {
    int g = item >> 1, d = item & 1;
    __syncthreads();
    if (tid < 64) {
      int pp = tid;
      float step = __expf(p.in[23][d * 64 + g]);
      float lr = p.in[21][(d * 64 + g) * 64 + pp], li = p.in[22][(d * 64 + g) * 64 + pp];
      float mag = __expf(lr * step), sn, cs; sincos_red(li * step, sn, cs);
      float ar = mag * cs, ai = mag * sn, den = lr * lr + li * li, nr = ar - 1.f, ni = ai;
      sF[pp * 2] = (nr * lr + ni * li) / den; sF[pp * 2 + 1] = (ni * lr - nr * li) / den;
      float pr = 1.f, pi = 0.f;
      for (int tau = 0; tau <= 32; ++tau) {
        apow[(tau * 64 + pp) * 2] = pr; apow[(tau * 64 + pp) * 2 + 1] = pi;
        float nr2 = pr * ar - pi * ai, ni2 = pr * ai + pi * ar; pr = nr2; pi = ni2;
      }
    }
    __syncthreads();
    for (int idx = tid; idx < 1024; idx += 256) {
      int pp = idx >> 4, c = idx & 15;
      float br = p.in[24][((size_t)(d * 64 + g) * 64 + pp) * 16 + c], bi = p.in[25][((size_t)(d * 64 + g) * 64 + pp) * 16 + c];
      float fr = sF[pp * 2], fi = sF[pp * 2 + 1];
      BB[idx * 2] = fr * br - fi * bi; BB[idx * 2 + 1] = fr * bi + fi * br;
      int c2 = idx >> 6, p2 = idx & 63;
      CC[idx * 2] = p.in[26][((size_t)(d * 64 + g) * 16 + c2) * 64 + p2]; CC[idx * 2 + 1] = p.in[27][((size_t)(d * 64 + g) * 16 + c2) * 64 + p2];
    }
    __syncthreads();
    {
      int c = tid >> 4, c1 = tid & 15;
      for (int tau = 0; tau < 32; ++tau) {
        float acc = 0.f;
        for (int pp = 0; pp < 64; ++pp) {
          float cr = CC[(c * 64 + pp) * 2], ci = CC[(c * 64 + pp) * 2 + 1];
          float pr = apow[(tau * 64 + pp) * 2], pi = apow[(tau * 64 + pp) * 2 + 1];
          float wr = cr * pr - ci * pi, wi = cr * pi + ci * pr;
          acc += wr * BB[(pp * 16 + c1) * 2] - wi * BB[(pp * 16 + c1) * 2 + 1];
        }
        Ktab[((size_t)(g * 2 + d) * 32 + tau) * 256 + c * 16 + c1] = acc;
      }
    }
    for (int idx = tid; idx < 128 * 512; idx += 256) {
      int nl = idx >> 9, k = idx & 511, ri = nl >> 6, pp = nl & 63, s = k >> 4, c1 = k & 15;
      int e = d == 0 ? 31 - s : s;
      float pr = apow[(e * 64 + pp) * 2], pi = apow[(e * 64 + pp) * 2 + 1];
      float br = BB[(pp * 16 + c1) * 2], bi = BB[(pp * 16 + c1) * 2 + 1];
      float v = ri ? (pr * bi + pi * br) : (pr * br - pi * bi);
      Bt1[((size_t)g * 256 + d * 128 + nl) * 512 + k] = (hf)(v * 256.f);
    }
    for (int idx = tid; idx < 512 * 128; idx += 256) {
      int n = idx >> 7, kk = idx & 127, ri = kk >> 6, pp = kk & 63, t = n >> 4, c = n & 15;
      int pw = d == 0 ? t + 1 : 32 - t;
      float cr = CC[(c * 64 + pp) * 2], ci = CC[(c * 64 + pp) * 2 + 1];
      float pr = apow[(pw * 64 + pp) * 2], pi = apow[(pw * 64 + pp) * 2 + 1];
      float v = ri ? -(cr * pi + ci * pr) : (cr * pr - ci * pi);
      Bt2[((size_t)g * 512 + n) * 768 + 512 + d * 128 + kk] = (hf)v;
    }
  }
}

__device__ __forceinline__ void s5_tabB(const Params& p) {
  const float* Ktab = (const float*)(p.ws + OFF_SMALL + SM_KTAB);
  hf* Bt2 = (hf*)(p.ws + OFF_S5M + 16 * MiB);
  const float* dsk = p.in[28];
  for (int idx = blockIdx.x * 256 + tidx(); idx < 64 * 512 * 64; idx += gridDim.x * 256) {
    int kc = idx & 63, n = (idx >> 6) & 511, g = idx >> 15;
    int t = n >> 4, c = n & 15, s = kc >> 1, c0 = (kc & 1) * 8;
    h8 o;
    if (t != s) {
      int d = t > s ? 0 : 1, tau = t > s ? t - s : s - t;
      const float* kp = Ktab + ((size_t)(g * 2 + d) * 32 + tau) * 256 + c * 16 + c0;
#pragma unroll
      for (int e = 0; e < 8; ++e) o[e] = (hf)(kp[e] * 256.f);
    } else {
      const float* k0 = Ktab + ((size_t)(g * 2 + 0) * 32) * 256 + c * 16 + c0;
      const float* k1 = Ktab + ((size_t)(g * 2 + 1) * 32) * 256 + c * 16 + c0;
      float ds = dsk[g * 16 + c];
#pragma unroll
      for (int e = 0; e < 8; ++e) o[e] = (hf)((k0[e] + k1[e] + ((c0 + e) == c ? ds : 0.f)) * 256.f);
    }
    *(h8*)(Bt2 + ((size_t)g * 512 + n) * 768 + kc * 8) = o;
  }
}

__device__ __forceinline__ void s5_carry(const Params& p) {
  const float* E = (const float*)(p.ws + OFF_RA);
  hf* us5 = (hf*)(p.ws + OFF_US5);
  for (int idx = blockIdx.x * 256 + tidx(); idx < 64 * 5 * 2 * 64; idx += gridDim.x * 256) {
    int pp = idx & 63, dd = (idx >> 6) & 1, sq = (idx >> 7) % 5, g = idx / 640;
    float step = __expf(p.in[23][dd * 64 + g]);
    float lr = p.in[21][(dd * 64 + g) * 64 + pp], li = p.in[22][(dd * 64 + g) * 64 + pp];
    float mag = __expf(lr * step), sn, cs; sincos_red(li * step, sn, cs);
    float ar = mag * cs, ai = mag * sn;
#pragma unroll
    for (int i = 0; i < 5; ++i) { float r2 = ar * ar - ai * ai, i2 = 2.f * ar * ai; ar = r2; ai = i2; }
    int c0 = seq_start(sq) >> 5, nc = seq_len(sq) >> 5;
    float cr = 0.f, ci = 0.f;
    int n = dd * 128 + pp;
    for (int j0 = 0; j0 < nc; j0 += 8) {
      float er[8], ei[8];
#pragma unroll
      for (int u = 0; u < 8; ++u) {
        int j = dd == 0 ? (j0 + u) : (nc - 1 - j0 - u);
        size_t o = ((size_t)g * 1536 + c0 + j) * 256 + n;
        er[u] = E[o]; ei[u] = E[o + 64];
      }
#pragma unroll
      for (int u = 0; u < 8; ++u) {
        int j = dd == 0 ? (j0 + u) : (nc - 1 - j0 - u);
        size_t o = ((size_t)g * 1536 + c0 + j) * 768 + 512 + n;
        us5[o] = (hf)cr; us5[o + 64] = (hf)ci;
        float nr = ar * cr - ai * ci + er[u], ni = ar * ci + ai * cr + ei[u]; cr = nr; ci = ni;
      }
    }
  }
}

__device__ __forceinline__ void norm_phase(const Params& p, int layer, int which, bool from_inputs) {
  const float* mod = (const float*)(p.ws + OFF_SMALL + SM_MOD) + (size_t)layer * 5 * 12288;
  const float* gain = (which == 0 ? p.in[6] : p.in[7]) + layer * 2048;
  hf* h16 = (hf*)(p.ws + OFF_RA);
  const int lane = tidx() & 63, gw = blockIdx.x * 4 + (tidx() >> 6), nw = gridDim.x * 4;
  const int o_sh = which == 0 ? 0 : 3 * 2048, o_sc = o_sh + 2048;
  for (int t = gw; t < T_TOK; t += nw) {
    const float* xr = from_inputs ? (t < 32768 ? p.in[0] + (size_t)t * 2048 : p.in[1] + (size_t)(t - 32768) * 2048) : p.out + (size_t)t * 2048;
    float4 v[8]; float ss = 0.f;
#pragma unroll
    for (int i = 0; i < 8; ++i) { v[i] = ((const float4*)xr)[i * 64 + lane]; ss += v[i].x * v[i].x + v[i].y * v[i].y + v[i].z * v[i].z + v[i].w * v[i].w; }
#pragma unroll
    for (int o = 32; o; o >>= 1) ss += __shfl_xor(ss, o);
    float r = rsqrtf(ss * (1.f / 2048.f) + 1e-6f);
    const float* m = mod + (size_t)seq_of(t) * 12288;
#pragma unroll
    for (int i = 0; i < 8; ++i) {
      int idx = (i * 64 + lane) * 4;
      float4 g4 = *(const float4*)(gain + idx), sc = *(const float4*)(m + o_sc + idx), sh = *(const float4*)(m + o_sh + idx);
      h4 o;
      o[0] = (hf)(v[i].x * r * g4.x * (1.f + sc.x) + sh.x); o[1] = (hf)(v[i].y * r * g4.y * (1.f + sc.y) + sh.y);
      o[2] = (hf)(v[i].z * r * g4.z * (1.f + sc.z) + sh.z); o[3] = (hf)(v[i].w * r * g4.w * (1.f + sc.w) + sh.w);
      *(h4*)(h16 + (size_t)t * 2048 + idx) = o;
      if (from_inputs) *(float4*)(p.out + (size_t)t * 2048 + idx) = v[i];
    }
  }
}

__device__ __forceinline__ void final_norm(const Params& p) {
  const int lane = tidx() & 63, gw = blockIdx.x * 4 + (tidx() >> 6), nw = gridDim.x * 4;
  for (int t = gw; t < T_TOK; t += nw) {
    float* xr = p.out + (size_t)t * 2048;
    float4 v[8]; float ss = 0.f;
#pragma unroll
    for (int i = 0; i < 8; ++i) { v[i] = ((const float4*)xr)[i * 64 + lane]; ss += v[i].x * v[i].x + v[i].y * v[i].y + v[i].z * v[i].z + v[i].w * v[i].w; }
#pragma unroll
    for (int o = 32; o; o >>= 1) ss += __shfl_xor(ss, o);
    float r = rsqrtf(ss * (1.f / 2048.f) + 1e-6f);
#pragma unroll
    for (int i = 0; i < 8; ++i) {
      int idx = (i * 64 + lane) * 4;
      float4 g4 = *(const float4*)(p.in[47] + idx);
      float4 o; o.x = v[i].x * r * g4.x; o.y = v[i].y * r * g4.y; o.z = v[i].z * r * g4.z; o.w = v[i].w * r * g4.w;
      *(float4*)(xr + idx) = o;
    }
  }
}

struct GemmArgs { const hf* A; size_t lda, sA; const hf* Bt; size_t ldb, sB; int M, N, K, nb; };

#define EPI_BEGIN _Pragma("unroll") for (int mi = 0; mi < 8; ++mi) _Pragma("unroll") for (int ni = 0; ni < 8; ++ni) { \
    const int row = row0 + mi * 16 + fr; const int c = col0 + ni * 16 + fq * 4; const f4 v = acc[mi][ni]; (void)row; (void)c; (void)b;
#define EPI_END __builtin_amdgcn_sched_barrier(0); }

constexpr int G_LD = 72;
constexpr int G_STAGE = 512 * G_LD;
constexpr int DYN_LDS = 2 * G_STAGE * 2;

template <class Epi>
__device__ __forceinline__ void gemm_run(const GemmArgs g, Epi epi, char* smem) {
  hf* sbase = (hf*)smem;
  const int tid = tidx(), lane = tid & 63, wv = tid >> 6, wm = wv >> 1, wn = wv & 1, fr = lane & 15, fq = lane >> 4;
  const int tm = g.M >> 8, tn = (g.N + 255) >> 8, per = tm * tn, total = per * g.nb, nk = g.K >> 6;
  const int lr = tid >> 3, lc = (tid & 7) * 8;
  for (int tile = blockIdx.x; tile < total; tile += gridDim.x) {
    int gidx = tile;
    if (gridDim.x == 256 && (tile | 255) < total) { const int s = tile & 255; gidx = (tile & ~255) + (s & 7) * 32 + (s >> 3); }
    const int b = gidx / per, r = gidx - b * per;
    const int band = r / (tm * 8), rbn = r - band * tm * 8, bw = min(8, tn - band * 8);
    const int mt = rbn / bw, nt = band * 8 + rbn - mt * bw;
    const hf* Ap = g.A + (size_t)b * g.sA + (size_t)(mt * 256 + lr) * g.lda + lc;
    const hf* Bp = g.Bt + (size_t)b * g.sB + lc;
    unsigned brow[8];
#pragma unroll
    for (int i = 0; i < 8; ++i) brow[i] = (unsigned)(min(nt * 256 + lr + 32 * i, g.N - 1) * (int)g.ldb);
    u4 ra[8], rb[8];
    f4 acc[8][8];
#pragma unroll
    for (int i = 0; i < 8; ++i)
#pragma unroll
      for (int j = 0; j < 8; ++j) acc[i][j] = (f4){0.f, 0.f, 0.f, 0.f};
    __syncthreads();
#pragma unroll
    for (int i = 0; i < 8; ++i) { ra[i] = *(const u4*)(Ap + (size_t)(32 * i) * g.lda); rb[i] = *(const u4*)(Bp + brow[i]); }
#pragma unroll
    for (int i = 0; i < 8; ++i) { *(u4*)(sbase + (lr + 32 * i) * G_LD + lc) = ra[i]; *(u4*)(sbase + (256 + lr + 32 * i) * G_LD + lc) = rb[i]; }
    if (nk > 1) {
#pragma unroll
      for (int i = 0; i < 8; ++i) { ra[i] = *(const u4*)(Ap + (size_t)(32 * i) * g.lda + 64); rb[i] = *(const u4*)(Bp + brow[i] + 64); }
    }
    __syncthreads();
    for (int kt = 0; kt < nk; ++kt) {
      if (kt + 1 < nk) {
        hf* st = sbase + ((kt + 1) & 1) * G_STAGE;
#pragma unroll
        for (int i = 0; i < 8; ++i) { *(u4*)(st + (lr + 32 * i) * G_LD + lc) = ra[i]; *(u4*)(st + (256 + lr + 32 * i) * G_LD + lc) = rb[i]; }
      }
      if (kt + 2 < nk) {
        const int ko = (kt + 2) * 64;
#pragma unroll
        for (int i = 0; i < 8; ++i) { ra[i] = *(const u4*)(Ap + (size_t)(32 * i) * g.lda + ko); rb[i] = *(const u4*)(Bp + brow[i] + ko); }
      }
      __builtin_amdgcn_sched_barrier(0);
      const hf* sA = sbase + (kt & 1) * G_STAGE + (wm * 128 + fr) * G_LD + fq * 8;
      const hf* sB = sbase + (kt & 1) * G_STAGE + (256 + wn * 128 + fr) * G_LD + fq * 8;
#pragma unroll
      for (int ks = 0; ks < 2; ++ks) {
        h8 af[8];
#pragma unroll
        for (int i = 0; i < 8; ++i) af[i] = *(const h8*)(sA + i * 16 * G_LD + ks * 32);
#pragma unroll
        for (int nh = 0; nh < 2; ++nh) {
          h8 bf[4];
#pragma unroll
          for (int i = 0; i < 4; ++i) bf[i] = *(const h8*)(sB + (nh * 4 + i) * 16 * G_LD + ks * 32);
#pragma unroll
          for (int mi = 0; mi < 8; ++mi)
#pragma unroll
            for (int ni = 0; ni < 4; ++ni) acc[mi][nh * 4 + ni] = mfma16(bf[ni], af[mi], acc[mi][nh * 4 + ni]);
          __builtin_amdgcn_sched_barrier(0);
        }
      }
      __syncthreads();
    }
    epi(acc, b, mt * 256 + wm * 128, nt * 256 + wn * 128, fr, fq);
  }
}

struct EpiInproj0 { hf* prw; hf* us5;
  DI void operator()(f4 (&acc)[8][8], int b, int row0, int col0, int fr, int fq) const {
    EPI_BEGIN
      if (c < 3456) *(h4*)(prw + (size_t)row * 3456 + c) = cvt4(v);
      else if (c < 4480) { int cu = c - 3456, g = cu >> 4, cc = cu & 15; *(h4*)(us5 + ((size_t)g * 1536 + (row >> 5)) * 768 + (row & 31) * 16 + cc) = cvt4(v); }
    EPI_END } };
struct EpiS5p1 { float* E;
  DI void operator()(f4 (&acc)[8][8], int b, int row0, int col0, int fr, int fq) const {
    EPI_BEGIN
      *(f4*)(E + ((size_t)b * 1536 + row) * 256 + c) = v;
    EPI_END } };
struct EpiS5p2 { hf* z16;
  DI void operator()(f4 (&acc)[8][8], int b, int row0, int col0, int fr, int fq) const {
    EPI_BEGIN
      int tok = row * 32 + (c >> 4), cc = c & 15; h4 o;
#pragma unroll
      for (int j = 0; j < 4; ++j) { float y = v[j] * (1.f / 256.f); float u = 0.7978845608f * (y + 0.044715f * y * y * y); float th = 1.f - 2.f / (1.f + __expf(2.f * u)); o[j] = (hf)(0.5f * y * (1.f + th)); }
      *(h4*)(z16 + (size_t)tok * 1024 + b * 16 + cc) = o;
    EPI_END } };
struct EpiGlu { const hf* z16; const float* bglu; hf* mix;
  DI void operator()(f4 (&acc)[8][8], int b, int row0, int col0, int fr, int fq) const {
    EPI_BEGIN
      h4 z = *(const h4*)(z16 + (size_t)row * 1024 + c); f4 bb = *(const f4*)(bglu + c); h4 o;
#pragma unroll
      for (int j = 0; j < 4; ++j) o[j] = (hf)((float)z[j] * sigmoidf_(v[j] + bb[j]));
      *(h4*)(mix + (size_t)row * 2048 + 1024 + c) = o;
    EPI_END } };
struct EpiStore { hf* dst; size_t ld;
  DI void operator()(f4 (&acc)[8][8], int b, int row0, int col0, int fr, int fq) const {
    EPI_BEGIN
      *(h4*)(dst + (size_t)row * ld + c) = cvt4(v);
    EPI_END } };
struct EpiResid { float* x; const float* gate; int tok0;
  DI void operator()(f4 (&acc)[8][8], int b, int row0, int col0, int fr, int fq) const {
    EPI_BEGIN
      int tok = tok0 + row; const float* gp = gate + (size_t)seq_of(tok) * 12288 + c; f4 gg = *(const f4*)gp;
      f4* xp = (f4*)(x + (size_t)tok * 2048 + c); f4 xv = *xp;
      xv[0] += gg[0] * v[0]; xv[1] += gg[1] * v[1]; xv[2] += gg[2] * v[2]; xv[3] += gg[3] * v[3]; *xp = xv;
    EPI_END } };
struct EpiInproj1 { hf* p1; hf* vtd;
  DI void operator()(f4 (&acc)[8][8], int b, int row0, int col0, int fr, int fq) const {
    EPI_BEGIN
      if (c < 2848) *(h4*)(p1 + (size_t)row * 2848 + c) = cvt4(v);
      else if (c < 3872) { int cd = c - 2848;
#pragma unroll
        for (int j = 0; j < 4; ++j) vtd[(size_t)(cd + j) * T_TOK + row] = (hf)v[j]; }
    EPI_END } };
struct EpiUkv { hf* km; hf* vtm;
  DI void operator()(f4 (&acc)[8][8], int b, int row0, int col0, int fr, int fq) const {
    EPI_BEGIN
      int head = c / 192, d = c - head * 192;
      if (d < 64) *(h4*)(km + ((size_t)row * 8 + head) * 96 + d) = cvt4(v);
      else {
#pragma unroll
        for (int j = 0; j < 4; ++j) vtm[(size_t)(head * 128 + d - 64 + j) * T_TOK + row] = (hf)v[j]; }
    EPI_END } };

template <int RPL>
__device__ __forceinline__ void rwkv_item(const Params& p, int seq, int head, int dir, int slab, char* smem) {
  float* sVec = (float*)smem;
  float* sV = sVec + 32 * 5 * 64;
  hf* sTw = (hf*)(sV + 32 * 64);
  hf* sDa = sTw + 32 * 72;
  float* sBon = (float*)(sDa + 32 * 72);
  const int tid = tidx(), lane = tid & 63, wv = tid >> 6, fr = lane & 15, fq = lane >> 4;
  const int L = seq_len(seq), s0 = seq_start(seq);
  const hf* P = (const hf*)(p.ws + OFF_RB);
  hf* yout = (hf*)(p.ws + OFF_RA) + (size_t)dir * T_TOK * 1024;
  float* bonus = (float*)(p.ws + OFF_SMALL + SM_BONUS);
  const float* mu = p.in[10];
  const int chg = head * 64 + wv * 16 + fr;
  h8 wf[2], af2[2];
#pragma unroll
  for (int ks = 0; ks < 2; ++ks)
#pragma unroll
    for (int e = 0; e < 8; ++e) {
      int r = ks * 32 + fq * 8 + e;
      wf[ks][e] = (hf)p.in[12][(size_t)(dir * 64 + r) * 1024 + chg];
      af2[ks][e] = (hf)p.in[14][(size_t)(dir * 64 + r) * 1024 + chg];
    }
  const float c_w0 = p.in[11][dir * 1024 + chg], c_a0 = p.in[13][dir * 1024 + chg], c_ka = p.in[17][chg], c_rk = p.in[18][chg];
  const int li_t = tid >> 3, part = tid & 7;
  int gcol[5] = {head * 64 + part * 8, 1024 + head * 64 + part * 8, 2048 + head * 64 + part * 8, 3072 + dir * 64 + part * 8, 3200 + dir * 64 + part * 8};
  u4 raw[5][3];
  const int nch = L >> 5;
  auto load_raw = [&](int c) {
    int t0 = dir ? L - 32 * (c + 1) : 32 * c; int tl = t0 + li_t;
#pragma unroll
    for (int g = 0; g < 5; ++g)
#pragma unroll
      for (int n = 0; n < 3; ++n) {
        int tt = tl + n - 1;
        raw[g][n] = (tt >= 0 && tt < L) ? *(const u4*)(P + (size_t)(s0 + tt) * 3456 + gcol[g]) : (u4){0u, 0u, 0u, 0u};
      }
  };
  float S[RPL][4];
#pragma unroll
  for (int r = 0; r < RPL; ++r) { S[r][0] = 0.f; S[r][1] = 0.f; S[r][2] = 0.f; S[r][3] = 0.f; }
  const int ks_ = tid & 15, rg = tid >> 4, rbase = slab * (16 * RPL) + rg * RPL;
  load_raw(0);
  for (int c = 0; c < nch; ++c) {
    const int t0 = dir ? L - 32 * (c + 1) : 32 * c;
    __syncthreads();
#pragma unroll
    for (int g = 0; g < 5; ++g) {
      h8 pv = __builtin_bit_cast(h8, raw[g][0]), cv = __builtin_bit_cast(h8, raw[g][1]), nv = __builtin_bit_cast(h8, raw[g][2]);
      float mx[8];
      const float4 m0 = *(const float4*)(mu + gcol[g]), m1 = *(const float4*)(mu + gcol[g] + 4);
      const float mm[8] = {m0.x, m0.y, m0.z, m0.w, m1.x, m1.y, m1.z, m1.w};
#pragma unroll
      for (int e = 0; e < 8; ++e) { float cu = (float)cv[e]; mx[e] = cu + mm[e] * (0.5f * ((float)pv[e] + (float)nv[e]) - cu); }
      if (g == 0) {
#pragma unroll
        for (int e = 0; e < 8; ++e) sVec[(li_t * 5 + 4) * 64 + part * 8 + e] = mx[e];
      } else if (g == 1) {
        const float4 k0 = *(const float4*)(p.in[16] + head * 64 + part * 8), k1 = *(const float4*)(p.in[16] + head * 64 + part * 8 + 4);
        const float kkc[8] = {k0.x, k0.y, k0.z, k0.w, k1.x, k1.y, k1.z, k1.w};
        float kkv[8], ss = 0.f;
#pragma unroll
        for (int e = 0; e < 8; ++e) { kkv[e] = mx[e] * kkc[e]; ss += kkv[e] * kkv[e]; sVec[(li_t * 5 + 3) * 64 + part * 8 + e] = mx[e]; }
        ss += __shfl_xor(ss, 1); ss += __shfl_xor(ss, 2); ss += __shfl_xor(ss, 4);
        float inv = 1.f / fmaxf(sqrtf(ss), 1e-12f);
#pragma unroll
        for (int e = 0; e < 8; ++e) sVec[(li_t * 5 + 1) * 64 + part * 8 + e] = kkv[e] * inv;
      } else if (g == 2) {
#pragma unroll
        for (int e = 0; e < 8; ++e) sV[li_t * 64 + part * 8 + e] = mx[e];
      } else if (g == 3) {
#pragma unroll
        for (int e = 0; e < 8; ++e) sTw[li_t * 72 + part * 8 + e] = (hf)(1.f - 2.f / (1.f + __expf(2.f * mx[e])));
      } else {
#pragma unroll
        for (int e = 0; e < 8; ++e) sDa[li_t * 72 + part * 8 + e] = (hf)mx[e];
      }
    }
    if (tid < 32) sBon[tid] = 0.f;
    __syncthreads();
    if (c + 1 < nch) load_raw(c + 1);
#pragma unroll
    for (int mt = 0; mt < 2; ++mt) {
      f4 accw = {0.f, 0.f, 0.f, 0.f}, acca = {0.f, 0.f, 0.f, 0.f};
#pragma unroll
      for (int ks = 0; ks < 2; ++ks) {
        h8 a1 = *(const h8*)(sTw + (mt * 16 + fr) * 72 + ks * 32 + fq * 8);
        h8 a2 = *(const h8*)(sDa + (mt * 16 + fr) * 72 + ks * 32 + fq * 8);
        accw = mfma16(a1, wf[ks], accw); acca = mfma16(a2, af2[ks], acca);
      }
      const int ch = wv * 16 + fr;
#pragma unroll
      for (int j = 0; j < 4; ++j) {
        int l2 = mt * 16 + fq * 4 + j;
        float dec = __expf(-0.6065306597f * sigmoidf_(c_w0 + accw[j]));
        float icl = sigmoidf_(c_a0 + acca[j]);
        float kx = sVec[(l2 * 5 + 3) * 64 + ch], kkv = sVec[(l2 * 5 + 1) * 64 + ch], rr = sVec[(l2 * 5 + 4) * 64 + ch];
        float kd = kx * (1.f + (icl - 1.f) * c_ka);
        sVec[(l2 * 5 + 0) * 64 + ch] = dec; sVec[(l2 * 5 + 2) * 64 + ch] = icl * kkv; sVec[(l2 * 5 + 3) * 64 + ch] = kd;
        float bon = rr * kd * c_rk;
        bon += __shfl_xor(bon, 1); bon += __shfl_xor(bon, 2); bon += __shfl_xor(bon, 4); bon += __shfl_xor(bon, 8);
        if (fr == 0) atomicAdd(&sBon[l2], bon);
      }
    }
    __syncthreads();
    if (slab == 0 && tid < 32) bonus[((size_t)(s0 + t0 + tid) * 16 + head) * 2 + dir] = sBon[tid];
#pragma unroll 4
    for (int i = 0; i < 32; ++i) {
      const int li = dir ? 31 - i : i;
      const float* base = sVec + li * 320 + ks_ * 4;
      const float4 w4 = *(const float4*)(base), kk4 = *(const float4*)(base + 64), b4 = *(const float4*)(base + 128),
                   kd4 = *(const float4*)(base + 192), r4 = *(const float4*)(base + 256);
#pragma unroll
      for (int r = 0; r < RPL; ++r) {
        const float vv = sV[li * 64 + rbase + r];
        float sa = S[r][0] * kk4.x + S[r][1] * kk4.y + S[r][2] * kk4.z + S[r][3] * kk4.w;
        sa = allred16(sa);
        S[r][0] = S[r][0] * w4.x - sa * b4.x + vv * kd4.x;
        S[r][1] = S[r][1] * w4.y - sa * b4.y + vv * kd4.y;
        S[r][2] = S[r][2] * w4.z - sa * b4.z + vv * kd4.z;
        S[r][3] = S[r][3] * w4.w - sa * b4.w + vv * kd4.w;
        float y = S[r][0] * r4.x + S[r][1] * r4.y + S[r][2] * r4.z + S[r][3] * r4.w;
        y = allred16(y);
        if (ks_ == 0) yout[(size_t)(s0 + t0 + li) * 1024 + head * 64 + rbase + r] = (hf)y;
      }
    }
  }
}

__device__ __forceinline__ void rwkv_scan_phase(const Params& p, char* smem) {
  for (int item = blockIdx.x; item < 384; item += gridDim.x) {
    if (item < 128) rwkv_item<1>(p, 4, item >> 3, (item >> 2) & 1, item & 3, smem);
    else { int it = item - 128; rwkv_item<2>(p, it >> 6, (it >> 2) & 15, (it >> 1) & 1, it & 1, smem); }
  }
}

__device__ __forceinline__ void gate_prep(const Params& p) {
  const hf* P = (const hf*)(p.ws + OFF_RB);
  hf* sg = (hf*)(p.ws + OFF_US5 + 96 * MiB);
  const float* mu = p.in[10];
  for (int idx = blockIdx.x * 256 + tidx(); idx < T_TOK * 16; idx += gridDim.x * 256) {
    int t = idx >> 4, part = idx & 15, col = 3328 + part * 8;
    int sq = seq_of(t), pos = t - seq_start(sq), L = seq_len(sq);
    h8 cv = *(const h8*)(P + (size_t)t * 3456 + col), pv, nv;
    for (int e = 0; e < 8; ++e) { pv[e] = (hf)0; nv[e] = (hf)0; }
    if (pos > 0) pv = *(const h8*)(P + (size_t)(t - 1) * 3456 + col);
    if (pos < L - 1) nv = *(const h8*)(P + (size_t)(t + 1) * 3456 + col);
    h8 o;
#pragma unroll
    for (int e = 0; e < 8; ++e) { float cu = (float)cv[e]; float mx = cu + mu[col + e] * (0.5f * ((float)pv[e] + (float)nv[e]) - cu); o[e] = (hf)sigmoidf_(mx); }
    *(h8*)(sg + (size_t)t * 128 + part * 8) = o;
  }
}

__device__ __forceinline__ void rwkv_post(const Params& p) {
  const hf* P = (const hf*)(p.ws + OFF_RB);
  const hf* y0 = (const hf*)(p.ws + OFF_RA); const hf* y1 = y0 + (size_t)T_TOK * 1024;
  const hf* g16 = (const hf*)(p.ws + OFF_US5);
  const float* bonus = (const float*)(p.ws + OFF_SMALL + SM_BONUS);
  hf* mix = (hf*)(p.ws + OFF_MIX0);
  const float* mu = p.in[10];
  const int lane = tidx() & 63, gw = blockIdx.x * 4 + (tidx() >> 6), nw = gridDim.x * 4;
  for (int t = gw; t < T_TOK; t += nw) {
    int sq = seq_of(t), pos = t - seq_start(sq), L = seq_len(sq);
    int ch0 = lane * 16, head = lane >> 2;
    float y[16]; float sum = 0.f;
#pragma unroll
    for (int q = 0; q < 2; ++q) {
      h8 a = *(const h8*)(y0 + (size_t)t * 1024 + ch0 + q * 8), bq = *(const h8*)(y1 + (size_t)t * 1024 + ch0 + q * 8);
#pragma unroll
      for (int e = 0; e < 8; ++e) { y[q * 8 + e] = (float)a[e] + (float)bq[e]; sum += y[q * 8 + e]; }
    }
    sum += __shfl_xor(sum, 1); sum += __shfl_xor(sum, 2);
    float mean = sum * (1.f / 64.f), var = 0.f;
#pragma unroll
    for (int e = 0; e < 16; ++e) { float dd = y[e] - mean; var += dd * dd; }
    var += __shfl_xor(var, 1); var += __shfl_xor(var, 2);
    float rs = rsqrtf(var * (1.f / 64.f) + 64e-5f);
    float bon = bonus[((size_t)t * 16 + head) * 2] + bonus[((size_t)t * 16 + head) * 2 + 1];
#pragma unroll
    for (int q = 0; q < 2; ++q) {
      int col = 2048 + ch0 + q * 8;
      h8 cv = *(const h8*)(P + (size_t)t * 3456 + col), pv, nv;
      for (int e = 0; e < 8; ++e) { pv[e] = (hf)0; nv[e] = (hf)0; }
      if (pos > 0) pv = *(const h8*)(P + (size_t)(t - 1) * 3456 + col);
      if (pos < L - 1) nv = *(const h8*)(P + (size_t)(t + 1) * 3456 + col);
      h8 gg = *(const h8*)(g16 + (size_t)t * 1024 + ch0 + q * 8), o;
#pragma unroll
      for (int e = 0; e < 8; ++e) {
        int ch = ch0 + q * 8 + e;
        float cu = (float)cv[e]; float vm = cu + mu[col + e] * (0.5f * ((float)pv[e] + (float)nv[e]) - cu);
        float yn = (y[q * 8 + e] - mean) * rs * p.in[19][ch] + p.in[20][ch] + bon * vm;
        o[e] = (hf)(yn * (float)gg[e]);
      }
      *(h8*)(mix + (size_t)t * 2048 + ch0 + q * 8) = o;
    }
  }
}

__device__ __forceinline__ void convact_phase(const Params& p, int layer, int slab) {
  const hf* U = (const hf*)(p.ws + OFF_RB); hf* act = (hf*)(p.ws + OFF_ACT);
  const float* cw = p.in[44] + (size_t)layer * 3 * 11264; const float* cb = p.in[45] + (size_t)layer * 11264;
  const int lmask = slab == 2 ? 16383 : 8191;
  for (int idx = blockIdx.x * 256 + tidx(); idx < 16384 * 704; idx += gridDim.x * 256) {
    int row = idx / 704, f0 = (idx - row * 704) * 8, pos = row & lmask;
    bool hp = pos > 0, hn = pos < lmask;
    float res[2][8];
#pragma unroll
    for (int hh = 0; hh < 2; ++hh) {
      int col = f0 + hh * 5632;
      h8 cv = *(const h8*)(U + (size_t)row * 11264 + col), pv, nv;
      for (int e = 0; e < 8; ++e) { pv[e] = (hf)0; nv[e] = (hf)0; }
      if (hp) pv = *(const h8*)(U + (size_t)(row - 1) * 11264 + col);
      if (hn) nv = *(const h8*)(U + (size_t)(row + 1) * 11264 + col);
#pragma unroll
      for (int e = 0; e < 8; ++e)
        res[hh][e] = (float)pv[e] * cw[col + e] + (float)cv[e] * cw[11264 + col + e] + (float)nv[e] * cw[22528 + col + e] + cb[col + e];
    }
    h8 o;
#pragma unroll
    for (int e = 0; e < 8; ++e) { float gt = res[1][e]; o[e] = (hf)(gt * sigmoidf_(gt) * res[0][e]); }
    *(h8*)(act + (size_t)row * 5632 + f0) = o;
  }
}

__device__ __forceinline__ void mla_prep(const Params& p) {
  const hf* p1 = (const hf*)(p.ws + OFF_RB);
  hf* cqn = (hf*)(p.ws + OFF_MIX1); hf* ckvn = (hf*)(p.ws + OFF_MIX1 + 48 * MiB);
  hf* km = (hf*)(p.ws + OFF_RA + 72 * MiB);
  const int lane = tidx() & 63, gw = blockIdx.x * 4 + (tidx() >> 6), nw = gridDim.x * 4;
  if (blockIdx.x == 0 && tidx() == 0) {
    float s1 = 0.f, s2 = 0.f;
    for (int i = 0; i < 64; ++i) { s1 += p.in[37][i] * p.in[38][i]; s2 += p.in[39][i] * p.in[40][i]; }
    float* lamp = (float*)(p.ws + OFF_SMALL + SM_CNT) + 8;
    lamp[0] = __expf(s1) - __expf(s2) + 0.35550906759f;
  }
  for (int t = gw; t < T_TOK; t += nw) {
    const hf* row = p1 + (size_t)t * 2848;
    h8 a = *(const h8*)(row + lane * 8); float ss = 0.f;
#pragma unroll
    for (int e = 0; e < 8; ++e) ss += (float)a[e] * (float)a[e];
#pragma unroll
    for (int o = 32; o; o >>= 1) ss += __shfl_xor(ss, o);
    float r = rsqrtf(ss * (1.f / 512.f) + 1e-6f); h8 o8;
#pragma unroll
    for (int e = 0; e < 8; ++e) o8[e] = (hf)((float)a[e] * r * p.in[33][lane * 8 + e]);
    *(h8*)(cqn + (size_t)t * 512 + lane * 8) = o8;
    h4 b4 = *(const h4*)(row + 512 + lane * 4); float s2 = 0.f;
#pragma unroll
    for (int e = 0; e < 4; ++e) s2 += (float)b4[e] * (float)b4[e];
#pragma unroll
    for (int o = 32; o; o >>= 1) s2 += __shfl_xor(s2, o);
    float r2 = rsqrtf(s2 * (1.f / 256.f) + 1e-6f); h4 o4;
#pragma unroll
    for (int e = 0; e < 4; ++e) o4[e] = (hf)((float)b4[e] * r2 * p.in[34][lane * 4 + e]);
    *(h4*)(ckvn + (size_t)t * 256 + lane * 4) = o4;
    if (lane < 16) {
      int pos = t - seq_start(seq_of(t));
      float inv = exp2f(-(float)lane * 0.830482023721841f);
      float sn, cs; sincos_red((float)pos * inv, sn, cs);
      float x1 = (float)row[768 + lane], x2 = (float)row[784 + lane];
      hf o1 = (hf)(x1 * cs - x2 * sn), o2 = (hf)(x1 * sn + x2 * cs);
#pragma unroll
      for (int h = 0; h < 8; ++h) { km[((size_t)t * 8 + h) * 96 + 64 + lane] = o1; km[((size_t)t * 8 + h) * 96 + 80 + lane] = o2; }
    }
  }
}

__device__ __forceinline__ void q_rope(const Params& p) {
  hf* qm = (hf*)(p.ws + OFF_RA);
  for (int idx = blockIdx.x * 256 + tidx(); idx < T_TOK * 128; idx += gridDim.x * 256) {
    int t = idx >> 7, h = (idx >> 4) & 7, i = idx & 15;
    int pos = t - seq_start(seq_of(t));
    float inv = exp2f(-(float)i * 0.830482023721841f);
    float sn, cs; sincos_red((float)pos * inv, sn, cs);
    hf* a = qm + ((size_t)t * 8 + h) * 96 + 64 + i;
    float x1 = (float)a[0], x2 = (float)a[16];
    a[0] = (hf)(x1 * cs - x2 * sn); a[16] = (hf)(x1 * sn + x2 * cs);
  }
}

template <int DQK, bool BIAS>
__device__ __forceinline__ void attn_pass(const hf* __restrict__ Q, int ldq, const hf* __restrict__ Kp, int ldk, const hf* __restrict__ VT,
                                          int s0, int L, int q0, float scale_l2, const float* sBias, f4 (&oacc)[8][2], char* smem) {
  constexpr int KS = DQK + 8, NKS = DQK / 32, KCH = DQK / 8, NKL = 64 * KCH / 256;
  hf* sK = (hf*)smem; hf* sVT = (hf*)(smem + 13312);
  const int tid = tidx(), lane = tid & 63, wv = tid >> 6, fr = lane & 15, fq = lane >> 4;
  h8 qf[2][NKS];
#pragma unroll
  for (int nq = 0; nq < 2; ++nq)
#pragma unroll
    for (int ks = 0; ks < NKS; ++ks) qf[nq][ks] = *(const h8*)(Q + (size_t)(s0 + q0 + wv * 32 + nq * 16 + fr) * ldq + ks * 32 + fq * 8);
  float mrun[2] = {-1e30f, -1e30f}, lrun[2] = {0.f, 0.f};
#pragma unroll
  for (int md = 0; md < 8; ++md) { oacc[md][0] = (f4){0.f, 0.f, 0.f, 0.f}; oacc[md][1] = (f4){0.f, 0.f, 0.f, 0.f}; }
  u4 rk[NKL], rv[4];
  auto loadKV = [&](int kt) {
    const int key0 = kt * 64;
#pragma unroll
    for (int i = 0; i < NKL; ++i) { int idx = tid + 256 * i, row = idx / KCH, ch = idx - row * KCH; rk[i] = *(const u4*)(Kp + (size_t)(s0 + key0 + row) * ldk + ch * 8); }
#pragma unroll
    for (int i = 0; i < 4; ++i) { int idx = tid + 256 * i, dv = idx >> 3, ch = idx & 7; rv[i] = *(const u4*)(VT + (size_t)dv * T_TOK + s0 + key0 + ch * 8); }
  };
  const int nkt = L >> 6;
  for (int kt = 0; kt < nkt; ++kt) {
    loadKV(kt);
    __syncthreads();
#pragma unroll
    for (int i = 0; i < NKL; ++i) { int idx = tid + 256 * i, row = idx / KCH, ch = idx - row * KCH; *(u4*)(sK + row * KS + ch * 8) = rk[i]; }
#pragma unroll
    for (int i = 0; i < 4; ++i) { int idx = tid + 256 * i, dv = idx >> 3, ch = idx & 7; *(u4*)(sVT + dv * 72 + ch * 8) = rv[i]; }
    __syncthreads();
    f4 sacc[4][2];
#pragma unroll
    for (int mk = 0; mk < 4; ++mk) { sacc[mk][0] = (f4){0.f, 0.f, 0.f, 0.f}; sacc[mk][1] = (f4){0.f, 0.f, 0.f, 0.f}; }
#pragma unroll
    for (int mk = 0; mk < 4; ++mk)
#pragma unroll
      for (int ks = 0; ks < NKS; ++ks) {
        h8 kf = *(const h8*)(sK + (mk * 16 + fr) * KS + ks * 32 + fq * 8);
        sacc[mk][0] = mfma16(kf, qf[0][ks], sacc[mk][0]); sacc[mk][1] = mfma16(kf, qf[1][ks], sacc[mk][1]);
        if (ks == NKS - 1 && (mk & 1)) __builtin_amdgcn_sched_barrier(0);
      }
    const int key0 = kt * 64;
    __builtin_amdgcn_sched_barrier(0);
    if (BIAS) {
      const int dmin = key0 - (q0 + 127), dmax = key0 + 63 - q0;
      if (dmax <= -91 || dmin >= 91) {
        const float add = dmax <= -91 ? sBias[0] : sBias[256];
#pragma unroll
        for (int mk = 0; mk < 4; ++mk)
#pragma unroll
          for (int nq = 0; nq < 2; ++nq)
#pragma unroll
            for (int j = 0; j < 4; ++j) sacc[mk][nq][j] = sacc[mk][nq][j] * scale_l2 + add;
      } else {
#pragma unroll
        for (int mk = 0; mk < 4; ++mk)
#pragma unroll
          for (int nq = 0; nq < 2; ++nq)
#pragma unroll
            for (int j = 0; j < 4; ++j) {
              int rel = (key0 + mk * 16 + fq * 4 + j) - (q0 + wv * 32 + nq * 16 + fr);
              rel = min(max(rel, -128), 128);
              sacc[mk][nq][j] = sacc[mk][nq][j] * scale_l2 + sBias[rel + 128];
            }
      }
    } else {
#pragma unroll
      for (int mk = 0; mk < 4; ++mk)
#pragma unroll
        for (int nq = 0; nq < 2; ++nq)
#pragma unroll
          for (int j = 0; j < 4; ++j) sacc[mk][nq][j] *= scale_l2;
    }
    __builtin_amdgcn_sched_barrier(0);
#pragma unroll
    for (int nq = 0; nq < 2; ++nq) {
      float mx = -1e30f;
#pragma unroll
      for (int mk = 0; mk < 4; ++mk)
#pragma unroll
        for (int j = 0; j < 4; ++j) mx = fmaxf(mx, sacc[mk][nq][j]);
      mx = fmaxf(mx, __shfl_xor(mx, 16)); mx = fmaxf(mx, __shfl_xor(mx, 32));
      const float mnew = fmaxf(mrun[nq], mx), alpha = __builtin_amdgcn_exp2f(mrun[nq] - mnew);
      mrun[nq] = mnew;
      float ps = 0.f;
#pragma unroll
      for (int mk = 0; mk < 4; ++mk)
#pragma unroll
        for (int j = 0; j < 4; ++j) { float pe = __builtin_amdgcn_exp2f(sacc[mk][nq][j] - mnew); sacc[mk][nq][j] = pe; ps += pe; }
      lrun[nq] = lrun[nq] * alpha + ps;
#pragma unroll
      for (int md = 0; md < 8; ++md) { oacc[md][nq][0] *= alpha; oacc[md][nq][1] *= alpha; oacc[md][nq][2] *= alpha; oacc[md][nq][3] *= alpha; }
      __builtin_amdgcn_sched_barrier(0);
    }
    h8 pf[2][2];
#pragma unroll
    for (int nq = 0; nq < 2; ++nq)
#pragma unroll
      for (int s2 = 0; s2 < 2; ++s2)
#pragma unroll
        for (int i = 0; i < 8; ++i) pf[nq][s2][i] = (hf)sacc[2 * s2 + (i >> 2)][nq][i & 3];
    __builtin_amdgcn_sched_barrier(0);
#pragma unroll
    for (int md = 0; md < 8; ++md)
#pragma unroll
      for (int s2 = 0; s2 < 2; ++s2) {
        h4 v0 = *(const h4*)(sVT + (md * 16 + fr) * 72 + s2 * 32 + fq * 4);
        h4 v1 = *(const h4*)(sVT + (md * 16 + fr) * 72 + s2 * 32 + 16 + fq * 4);
        h8 vf = __builtin_shufflevector(v0, v1, 0, 1, 2, 3, 4, 5, 6, 7);
        oacc[md][0] = mfma16(vf, pf[0][s2], oacc[md][0]); oacc[md][1] = mfma16(vf, pf[1][s2], oacc[md][1]);
        if (s2 == 1 && (md & 1)) __builtin_amdgcn_sched_barrier(0);
      }
  }
#pragma unroll
  for (int nq = 0; nq < 2; ++nq) {
    float lt = lrun[nq]; lt += __shfl_xor(lt, 16); lt += __shfl_xor(lt, 32);
    const float inv = 1.f / lt;
#pragma unroll
    for (int md = 0; md < 8; ++md) { oacc[md][nq][0] *= inv; oacc[md][nq][1] *= inv; oacc[md][nq][2] *= inv; oacc[md][nq][3] *= inv; }
  }
}

__device__ __forceinline__ void attn_phase(const Params& p, char* smem) {
  __shared__ int sItem;
  int* counter = (int*)(p.ws + OFF_SMALL + SM_CNT);
  const float lam = ((const float*)(p.ws + OFF_SMALL + SM_CNT))[8];
  float* sBias = (float*)(smem + 13312 + 18432);
  const hf* p1 = (const hf*)(p.ws + OFF_RB);
  const hf* vtd = (const hf*)(p.ws + OFF_VTD); const hf* vtm = (const hf*)(p.ws + OFF_VTM);
  const hf* qm = (const hf*)(p.ws + OFF_RA); const hf* km = (const hf*)(p.ws + OFF_RA + 72 * MiB);
  hf* mix = (hf*)(p.ws + OFF_MIX1);
  const int tid = tidx(), lane = tid & 63, wv = tid >> 6, fr = lane & 15, fq = lane >> 4;
  while (true) {
    __syncthreads();
    if (tid == 0) sItem = atomicAdd(counter, 1);
    __syncthreads();
    const int item = sItem;
    if (item >= 3072) break;
    int seq, h, qt;
    if (item < 1024) { seq = 4; h = item >> 7; qt = item & 127; }
    else { int it = item - 1024; seq = it >> 9; h = (it >> 6) & 7; qt = it & 63; }
    const int s0 = seq_start(seq), L = seq_len(seq), q0 = qt * 128;
    for (int i = tid; i < 257; i += 256) {
      int rel = i - 128, n = rel < 0 ? -rel : rel;
      int bk = n < 8 ? n : (n < 12 ? 8 : n < 16 ? 9 : n < 23 ? 10 : n < 32 ? 11 : n < 46 ? 12 : n < 64 ? 13 : n < 91 ? 14 : 15);
      if (rel > 0) bk += 16;
      sBias[i] = p.in[42][bk * 8 + h] * 1.44269504089f;
    }
#pragma unroll 1
    for (int m = 0; m < 2; ++m) {
      f4 oacc[8][2];
      attn_pass<64, true>(p1 + 800 + h * 128 + m * 64, 2848, p1 + 1824 + h * 128 + m * 64, 2848, vtd + (size_t)h * 128 * T_TOK, s0, L, q0,
                          0.125f * 1.44269504089f, sBias, oacc, smem);
      if (m == 0) {
#pragma unroll
        for (int nq = 0; nq < 2; ++nq)
#pragma unroll
          for (int md = 0; md < 8; ++md)
            *(h4*)(mix + (size_t)(s0 + q0 + wv * 32 + nq * 16 + fr) * 2048 + 1024 + h * 128 + md * 16 + fq * 4) = cvt4(oacc[md][nq]);
      } else {
#pragma unroll
        for (int nq = 0; nq < 2; ++nq) {
          hf* dst = mix + (size_t)(s0 + q0 + wv * 32 + nq * 16 + fr) * 2048 + 1024 + h * 128 + fq * 4;
          float ss = 0.f;
#pragma unroll
          for (int md = 0; md < 8; ++md) {
            h4 o0 = *(const h4*)(dst + md * 16);
#pragma unroll
            for (int j = 0; j < 4; ++j) { float o = (float)o0[j] - lam * oacc[md][nq][j]; oacc[md][nq][j] = o; ss += o * o; }
          }
          ss += __shfl_xor(ss, 16); ss += __shfl_xor(ss, 32);
          const float r = rsqrtf(ss * (1.f / 128.f) + 1e-5f) * (1.f - 0.35550906759f);
#pragma unroll
          for (int md = 0; md < 8; ++md) {
            f4 gg = *(const f4*)(p.in[41] + md * 16 + fq * 4); h4 o;
#pragma unroll
            for (int j = 0; j < 4; ++j) o[j] = (hf)(oacc[md][nq][j] * r * gg[j]);
            *(h4*)(dst + md * 16) = o;
          }
        }
      }
    }
  }
  while (true) {
    __syncthreads();
    if (tid == 0) sItem = atomicAdd(counter + 1, 1);
    __syncthreads();
    const int item = sItem;
    if (item >= 3072) break;
    int seq, h, qt;
    if (item < 1024) { seq = 4; h = item >> 7; qt = item & 127; }
    else { int it = item - 1024; seq = it >> 9; h = (it >> 6) & 7; qt = it & 63; }
    const int s0 = seq_start(seq), L = seq_len(seq), q0 = qt * 128;
    f4 oacc[8][2];
    attn_pass<96, false>(qm + h * 96, 768, km + h * 96, 768, vtm + (size_t)h * 128 * T_TOK, s0, L, q0, 0.10206207262f * 1.44269504089f, nullptr, oacc, smem);
#pragma unroll
    for (int nq = 0; nq < 2; ++nq)
#pragma unroll
      for (int md = 0; md < 8; ++md)
        *(h4*)(mix + (size_t)(s0 + q0 + wv * 32 + nq * 16 + fr) * 2048 + h * 128 + md * 16 + fq * 4) = cvt4(oacc[md][nq]);
  }
}

__device__ __forceinline__ void ffn_layer(const Params& p, cg::grid_group& grid, int layer, char* smem) {
  const hf* W = (const hf*)(p.ws + OFF_W);
  const hf* wup = W + (layer == 0 ? W0_FUP : W1_FUP); const hf* wdn = W + (layer == 0 ? W0_FDN : W1_FDN);
  const hf* h16 = (const hf*)(p.ws + OFF_RA);
  hf* u16 = (hf*)(p.ws + OFF_RB); hf* act = (hf*)(p.ws + OFF_ACT);
  const float* mod = (const float*)(p.ws + OFF_SMALL + SM_MOD) + (size_t)layer * 5 * 12288;
  for (int slab = 0; slab < 3; ++slab) {
    gemm_run(GemmArgs{h16 + (size_t)slab * 16384 * 2048, 2048, 0, wup, 2048, 0, 16384, 11264, 2048, 1}, EpiStore{u16, 11264}, smem);
    grid.sync();
    convact_phase(p, layer, slab);
    grid.sync();
    gemm_run(GemmArgs{act, 5632, 0, wdn, 5632, 0, 16384, 2048, 5632, 1}, EpiResid{p.out, mod + 5 * 2048, slab * 16384}, smem);
    grid.sync();
  }
}

__global__ void __launch_bounds__(256, 1) mega(Params p) {
  cg::grid_group grid = cg::this_grid();
  extern __shared__ __attribute__((aligned(16))) char smem[];
  hf* W = (hf*)(p.ws + OFF_W);
  float* mod = (float*)(p.ws + OFF_SMALL + SM_MOD);

  if (blockIdx.x == 0 && tidx() == 0) { int* cnt = (int*)(p.ws + OFF_SMALL + SM_CNT); cnt[0] = 0; cnt[1] = 0; }
  adaln_phase(p, smem);
  s5_tabA(p, smem);
  cvt_t(p.in[8], W + W0_IN, 2048, 4480, smem);
  cvt_t(p.in[9], W + W0_OUT, 2048, 2048, smem);
  cvt_t(p.in[29], W + W0_GLU, 1024, 1024, smem);
  cvt_t(p.in[15], W + W0_GUP, 128, 1024, smem);
  cvt_t(p.in[43], W + W0_FUP, 2048, 11264, smem);
  cvt_t(p.in[46], W + W0_FDN, 5632, 2048, smem);
  grid.sync();
  norm_phase(p, 0, 0, true);
  s5_tabB(p);
  grid.sync();
  gemm_run(GemmArgs{(const hf*)(p.ws + OFF_RA), 2048, 0, W + W0_IN, 2048, 0, T_TOK, 4480, 2048, 1},
           EpiInproj0{(hf*)(p.ws + OFF_RB), (hf*)(p.ws + OFF_US5)}, smem);
  grid.sync();
  gemm_run(GemmArgs{(const hf*)(p.ws + OFF_US5), 768, (size_t)1536 * 768, (const hf*)(p.ws + OFF_S5M), 512, (size_t)256 * 512, 1536, 256, 512, 64},
           EpiS5p1{(float*)(p.ws + OFF_RA)}, smem);
  grid.sync();
  s5_carry(p);
  grid.sync();
  gemm_run(GemmArgs{(const hf*)(p.ws + OFF_US5), 768, (size_t)1536 * 768, (const hf*)(p.ws + OFF_S5M + 16 * MiB), 768, (size_t)512 * 768, 1536, 512, 768, 64},
           EpiS5p2{(hf*)(p.ws + OFF_RA + 96 * MiB)}, smem);
  grid.sync();
  gemm_run(GemmArgs{(const hf*)(p.ws + OFF_RA + 96 * MiB), 1024, 0, W + W0_GLU, 1024, 0, T_TOK, 1024, 1024, 1},
           EpiGlu{(const hf*)(p.ws + OFF_RA + 96 * MiB), p.in[30], (hf*)(p.ws + OFF_MIX0)}, smem);
  gate_prep(p);
  grid.sync();
  gemm_run(GemmArgs{(const hf*)(p.ws + OFF_US5 + 96 * MiB), 128, 0, W + W0_GUP, 128, 0, T_TOK, 1024, 128, 1},
           EpiStore{(hf*)(p.ws + OFF_US5), 1024}, smem);
  rwkv_scan_phase(p, smem);
  grid.sync();
  rwkv_post(p);
  grid.sync();
  gemm_run(GemmArgs{(const hf*)(p.ws + OFF_MIX0), 2048, 0, W + W0_OUT, 2048, 0, T_TOK, 2048, 2048, 1},
           EpiResid{p.out, mod + 2 * 2048, 0}, smem);
  grid.sync();
  norm_phase(p, 0, 1, false);
  grid.sync();
  ffn_layer(p, grid, 0, smem);
  cvt_t(p.in[31], W + W1_IN, 2048, 3872, smem);
  cvt_t(p.in[32], W + W1_OUT, 2048, 2048, smem);
  cvt_t(p.in[35], W + W1_UQ, 512, 768, smem);
  cvt_t(p.in[36], W + W1_UKV, 256, 1536, smem);
  cvt_t(p.in[43] + (size_t)2048 * 11264, W + W1_FUP, 2048, 11264, smem);
  cvt_t(p.in[46] + (size_t)5632 * 2048, W + W1_FDN, 5632, 2048, smem);
  norm_phase(p, 1, 0, false);
  grid.sync();
  gemm_run(GemmArgs{(const hf*)(p.ws + OFF_RA), 2048, 0, W + W1_IN, 2048, 0, T_TOK, 3872, 2048, 1},
           EpiInproj1{(hf*)(p.ws + OFF_RB), (hf*)(p.ws + OFF_VTD)}, smem);
  grid.sync();
  mla_prep(p);
  grid.sync();
  gemm_run(GemmArgs{(const hf*)(p.ws + OFF_MIX1), 512, 0, W + W1_UQ, 512, 0, T_TOK, 768, 512, 1},
           EpiStore{(hf*)(p.ws + OFF_RA), 768}, smem);
  gemm_run(GemmArgs{(const hf*)(p.ws + OFF_MIX1 + 48 * MiB), 256, 0, W + W1_UKV, 256, 0, T_TOK, 1536, 256, 1},
           EpiUkv{(hf*)(p.ws + OFF_RA + 72 * MiB), (hf*)(p.ws + OFF_VTM)}, smem);
  grid.sync();
  q_rope(p);
  grid.sync();
  attn_phase(p, smem);
  grid.sync();
  gemm_run(GemmArgs{(const hf*)(p.ws + OFF_MIX1), 2048, 0, W + W1_OUT, 2048, 0, T_TOK, 2048, 2048, 1},
           EpiResid{p.out, mod + (size_t)5 * 12288 + 2 * 2048, 0}, smem);
  grid.sync();
  norm_phase(p, 1, 1, false);
  grid.sync();
  ffn_layer(p, grid, 1, smem);
  final_norm(p);
}

extern "C" void kernel_launch(void* const* d_in, const int* in_sizes, int n_in, void* d_out, int out_size,
                              void* d_ws, size_t ws_size, hipStream_t stream) {
  static int grid_blocks = 0;
  if (!grid_blocks) {
    int dev = 0, cus = 0, per_cu = 0;
    (void)hipGetDevice(&dev);
    (void)hipDeviceGetAttribute(&cus, hipDeviceAttributeMultiprocessorCount, dev);
    (void)hipFuncSetAttribute((const void*)mega, hipFuncAttributeMaxDynamicSharedMemorySize, DYN_LDS);
    (void)hipOccupancyMaxActiveBlocksPerMultiprocessor(&per_cu, mega, 256, DYN_LDS);
    if (per_cu > 2) per_cu = 2;
    if (per_cu < 1) per_cu = 1;
    grid_blocks = cus * per_cu;
  }
  Params p{};
  for (int i = 0; i < 48; ++i) p.in[i] = (const float*)d_in[i];
  p.out = (float*)d_out; p.ws = (char*)d_ws; p.stop = STOP_AT;
  void* args[] = {&p};
  hipError_t e = hipLaunchCooperativeKernel((void*)mega, dim3(grid_blocks), dim3(256), args, DYN_LDS, stream);
  if (e != hipSuccess) fprintf(stderr, "cooperative launch failed: %s (grid %d)\n", hipGetErrorString(e), grid_blocks);
}
```

```cpp
#include <hip/hip_runtime.h>
#include <hip/hip_cooperative_groups.h>
#include <cstdio>
#include <cstdint>
namespace cg = cooperative_groups;
typedef _Float16 hf;
using h8 = __attribute__((ext_vector_type(8))) _Float16;
using h4 = __attribute__((ext_vector_type(4))) _Float16;
using f4 = __attribute__((ext_vector_type(4))) float;
using u4 = __attribute__((ext_vector_type(4))) unsigned;

#define T_TOK 49152
#ifndef STOP_AT
#define STOP_AT 100
#endif
#define DI __device__ __forceinline__
constexpr size_t MiB = 1ull << 20;

struct Params {
  const float* in[48];
  float* out;
  char* ws;
  long stop;
};

constexpr size_t OFF_W = 0;
constexpr size_t OFF_RA = 96 * MiB;
constexpr size_t OFF_RB = 288 * MiB;
constexpr size_t OFF_US5 = 612 * MiB;
constexpr size_t OFF_MIX0 = 756 * MiB;
constexpr size_t OFF_S5M = 948 * MiB;
constexpr size_t OFF_SMALL = 1012 * MiB;
constexpr size_t OFF_ACT = 640 * MiB;
constexpr size_t OFF_VTD = 555 * MiB;
constexpr size_t OFF_VTM = 651 * MiB;
constexpr size_t OFF_MIX1 = 747 * MiB;
constexpr size_t SM_MOD = 0;
constexpr size_t SM_CNT = 512 * 1024;
constexpr size_t SM_KTAB = 1 * MiB;
constexpr size_t SM_BONUS = 5 * MiB;
constexpr size_t W0_IN = 0, W0_OUT = 9175040, W0_GLU = 13369344, W0_GUP = 14417920, W0_FUP = 14548992, W0_FDN = 37617664;
constexpr size_t W1_IN = 0, W1_OUT = 7929856, W1_UQ = 12124160, W1_UKV = 12517376, W1_FUP = 12910592, W1_FDN = 35979264;

DI int tidx() { int t = __builtin_amdgcn_workitem_id_x(); asm volatile("" : "+v"(t)); return t; }
DI float shx(float x, int m) {
  const int xi = __builtin_bit_cast(int, x); int r;
  switch (m) {
    case 1: r = __builtin_amdgcn_ds_swizzle(xi, 0x041f); break;
    case 2: r = __builtin_amdgcn_ds_swizzle(xi, 0x081f); break;
    case 4: r = __builtin_amdgcn_ds_swizzle(xi, 0x101f); break;
    case 8: r = __builtin_amdgcn_ds_swizzle(xi, 0x201f); break;
    case 16: r = __builtin_amdgcn_ds_swizzle(xi, 0x401f); break;
    default: r = __builtin_amdgcn_ds_bpermute(((tidx() & 63) ^ m) << 2, xi); break;
  }
  return __builtin_bit_cast(float, r);
}
DI int seq_of(int t) { return t < 32768 ? (t >> 13) : 4; }
DI int seq_start(int s) { return s < 4 ? s * 8192 : 32768; }
DI int seq_len(int s) { return s < 4 ? 8192 : 16384; }
DI float sigmoidf_(float x) { return 1.f / (1.f + __expf(-x)); }
DI h4 cvt4(f4 v) { h4 r; r[0] = (hf)v[0]; r[1] = (hf)v[1]; r[2] = (hf)v[2]; r[3] = (hf)v[3]; return r; }
DI void sincos_red(float x, float& s, float& c) {
  double a = (double)x; double n = rint(a * 0.15915494309189535); float r = (float)(a - n * 6.283185307179586);
  s = __sinf(r); c = __cosf(r);
}
DI float allred16(float x) {
  x += __builtin_bit_cast(float, __builtin_amdgcn_update_dpp(0, __builtin_bit_cast(int, x), 0x128, 0xf, 0xf, false));
  x += __builtin_bit_cast(float, __builtin_amdgcn_update_dpp(0, __builtin_bit_cast(int, x), 0x124, 0xf, 0xf, false));
  x += __builtin_bit_cast(float, __builtin_amdgcn_update_dpp(0, __builtin_bit_cast(int, x), 0x122, 0xf, 0xf, false));
  x += __builtin_bit_cast(float, __builtin_amdgcn_update_dpp(0, __builtin_bit_cast(int, x), 0x121, 0xf, 0xf, false));
  return x;
}
DI f4 mfma16(h8 a, h8 b, f4 c) { return __builtin_amdgcn_mfma_f32_16x16x32_f16(a, b, c, 0, 0, 0); }

__device__ __forceinline__ void cvt_t(const float* __restrict__ src, hf* __restrict__ dst, int K, int N, char* smem) {
  float* tile = (float*)smem;
  const int tk = K >> 6, tn = N >> 5, total = tk * tn, tid = tidx();
  for (int t = blockIdx.x; t < total; t += gridDim.x) {
    int kt = t / tn, nt = t - kt * tn;
    __syncthreads();
    int n = tid & 31, kr = tid >> 5;
#pragma unroll
    for (int i = 0; i < 8; ++i) tile[(kr + 8 * i) * 33 + n] = src[(size_t)(kt * 64 + kr + 8 * i) * N + nt * 32 + n];
    __syncthreads();
    int on = tid >> 3, ok = (tid & 7) * 8;
    h8 o;
#pragma unroll
    for (int e = 0; e < 8; ++e) o[e] = (hf)tile[(ok + e) * 33 + on];
    *(h8*)(dst + (size_t)(nt * 32 + on) * K + kt * 64 + ok) = o;
  }
}

__device__ __forceinline__ void adaln_phase(const Params& p, char* smem) {
  float* scs = (float*)smem;
  float* red = scs + 5 * 2048;
  float* mod = (float*)(p.ws + OFF_SMALL + SM_MOD);
  const int tid = tidx();
  __syncthreads();
  for (int i = tid; i < 5 * 2048; i += 256) {
    int s = i >> 11, k = i & 2047;
    float c = s < 4 ? p.in[2][s * 2048 + k] : p.in[3][k];
    scs[i] = c / (1.f + __expf(-c));
  }
  __syncthreads();
  for (int item = blockIdx.x; item < 384; item += gridDim.x) {
    int layer = item / 192, cb = item % 192, cl = tid & 63, kp = tid >> 6, col = cb * 64 + cl;
    const float* w = p.in[4] + (size_t)layer * 2048 * 12288 + col;
    float a0 = 0, a1 = 0, a2 = 0, a3 = 0, a4 = 0;
#pragma unroll 8
    for (int k = kp * 512; k < kp * 512 + 512; ++k) {
      float wv = w[(size_t)k * 12288];
      a0 += scs[k] * wv; a1 += scs[2048 + k] * wv; a2 += scs[4096 + k] * wv; a3 += scs[6144 + k] * wv; a4 += scs[8192 + k] * wv;
    }
    red[(kp * 5 + 0) * 64 + cl] = a0; red[(kp * 5 + 1) * 64 + cl] = a1; red[(kp * 5 + 2) * 64 + cl] = a2;
    red[(kp * 5 + 3) * 64 + cl] = a3; red[(kp * 5 + 4) * 64 + cl] = a4;
    __syncthreads();
    if (kp == 0) {
      float bb = p.in[5][layer * 12288 + col];
#pragma unroll
      for (int s = 0; s < 5; ++s)
        mod[(size_t)(layer * 5 + s) * 12288 + col] = red[s * 64 + cl] + red[(5 + s) * 64 + cl] + red[(10 + s) * 64 + cl] + red[(15 + s) * 64 + cl] + bb;
    }
    __syncthreads();
  }
}

__device__ __forceinline__ void s5_tabA(const Params& p, char* smem) {
  float* apow = (float*)smem;
  float* BB = apow + 33 * 128;
  float* CC = BB + 2048;
  float* sF = CC + 2048;
  float* Ktab = (float*)(p.ws + OFF_SMALL + SM_KTAB);
  hf* Bt1 = (hf*)(p.ws + OFF_S5M);
  hf* Bt2 = (hf*)(p.ws + OFF_S5M + 16 * MiB);
  const int tid = tidx();
  for (int item = blockIdx.x; item < 128; item += gridDim.x) {
    int g = item >> 1, d = item & 1;
    __syncthreads();
    if (tid < 64) {
      int pp = tid;
      float step = __expf(p.in[23][d * 64 + g]);
      float lr = p.in[21][(d * 64 + g) * 64 + pp], li = p.in[22][(d * 64 + g) * 64 + pp];
      float mag = __expf(lr * step), sn, cs; sincos_red(li * step, sn, cs);
      float ar = mag * cs, ai = mag * sn, den = lr * lr + li * li, nr = ar - 1.f, ni = ai;
      sF[pp * 2] = (nr * lr + ni * li) / den; sF[pp * 2 + 1] = (ni * lr - nr * li) / den;
      float pr = 1.f, pi = 0.f;
      for (int tau = 0; tau <= 32; ++tau) {
        apow[(tau * 64 + pp) * 2] = pr; apow[(tau * 64 + pp) * 2 + 1] = pi;
        float nr2 = pr * ar - pi * ai, ni2 = pr * ai + pi * ar; pr = nr2; pi = ni2;
      }
    }
    __syncthreads();
    for (int idx = tid; idx < 1024; idx += 256) {
      int pp = idx >> 4, c = idx & 15;
      float br = p.in[24][((size_t)(d * 64 + g) * 64 + pp) * 16 + c], bi = p.in[25][((size_t)(d * 64 + g) * 64 + pp) * 16 + c];
      float fr = sF[pp * 2], fi = sF[pp * 2 + 1];
      BB[idx * 2] = fr * br - fi * bi; BB[idx * 2 + 1] = fr * bi + fi * br;
      int c2 = idx >> 6, p2 = idx & 63;
      CC[idx * 2] = p.in[26][((size_t)(d * 64 + g) * 16 + c2) * 64 + p2]; CC[idx * 2 + 1] = p.in[27][((size_t)(d * 64 + g) * 16 + c2) * 64 + p2];
    }
    __syncthreads();
    {
      int c = tid >> 4, c1 = tid & 15;
      for (int tau = 0; tau < 32; ++tau) {
        float acc = 0.f;
        for (int pp = 0; pp < 64; ++pp) {
          float cr = CC[(c * 64 + pp) * 2], ci = CC[(c * 64 + pp) * 2 + 1];
          float pr = apow[(tau * 64 + pp) * 2], pi = apow[(tau * 64 + pp) * 2 + 1];
          float wr = cr * pr - ci * pi, wi = cr * pi + ci * pr;
          acc += wr * BB[(pp * 16 + c1) * 2] - wi * BB[(pp * 16 + c1) * 2 + 1];
        }
        Ktab[((size_t)(g * 2 + d) * 32 + tau) * 256 + c * 16 + c1] = acc;
      }
    }
    for (int idx = tid; idx < 128 * 512; idx += 256) {
      int nl = idx >> 9, k = idx & 511, ri = nl >> 6, pp = nl & 63, s = k >> 4, c1 = k & 15;
      int e = d == 0 ? 31 - s : s;
      float pr = apow[(e * 64 + pp) * 2], pi = apow[(e * 64 + pp) * 2 + 1];
      float br = BB[(pp * 16 + c1) * 2], bi = BB[(pp * 16 + c1) * 2 + 1];
      float v = ri ? (pr * bi + pi * br) : (pr * br - pi * bi);
      Bt1[((size_t)g * 256 + d * 128 + nl) * 512 + k] = (hf)(v * 256.f);
    }
    for (int idx = tid; idx < 512 * 128; idx += 256) {
      int n = idx >> 7, kk = idx & 127, ri = kk >> 6, pp = kk & 63, t = n >> 4, c = n & 15;
      int pw = d == 0 ? t + 1 : 32 - t;
      float cr = CC[(c * 64 + pp) * 2], ci = CC[(c * 64 + pp) * 2 + 1];
      float pr = apow[(pw * 64 + pp) * 2], pi = apow[(pw * 64 + pp) * 2 + 1];
      float v = ri ? -(cr * pi + ci * pr) : (cr * pr - ci * pi);
      Bt2[((size_t)g * 512 + n) * 768 + 512 + d * 128 + kk] = (hf)v;
    }
  }
}

__device__ __forceinline__ void s5_tabB(const Params& p) {
  const float* Ktab = (const float*)(p.ws + OFF_SMALL + SM_KTAB);
  hf* Bt2 = (hf*)(p.ws + OFF_S5M + 16 * MiB);
  const float* dsk = p.in[28];
  for (int idx = blockIdx.x * 256 + tidx(); idx < 64 * 512 * 64; idx += gridDim.x * 256) {
    int kc = idx & 63, n = (idx >> 6) & 511, g = idx >> 15;
    int t = n >> 4, c = n & 15, s = kc >> 1, c0 = (kc & 1) * 8;
    h8 o;
    if (t != s) {
      int d = t > s ? 0 : 1, tau = t > s ? t - s : s - t;
      const float* kp = Ktab + ((size_t)(g * 2 + d) * 32 + tau) * 256 + c * 16 + c0;
#pragma unroll
      for (int e = 0; e < 8; ++e) o[e] = (hf)(kp[e] * 256.f);
    } else {
      const float* k0 = Ktab + ((size_t)(g * 2 + 0) * 32) * 256 + c * 16 + c0;
      const float* k1 = Ktab + ((size_t)(g * 2 + 1) * 32) * 256 + c * 16 + c0;
      float ds = dsk[g * 16 + c];
#pragma unroll
      for (int e = 0; e < 8; ++e) o[e] = (hf)((k0[e] + k1[e] + ((c0 + e) == c ? ds : 0.f)) * 256.f);
    }
    *(h8*)(Bt2 + ((size_t)g * 512 + n) * 768 + kc * 8) = o;
  }
}

__device__ __forceinline__ void s5_carry(const Params& p) {
  const float* E = (const float*)(p.ws + OFF_RA);
  hf* us5 = (hf*)(p.ws + OFF_US5);
  for (int idx = blockIdx.x * 256 + tidx(); idx < 64 * 5 * 2 * 64; idx += gridDim.x * 256) {
    int pp = idx & 63, dd = (idx >> 6) & 1, sq = (idx >> 7) % 5, g = idx / 640;
    float step = __expf(p.in[23][dd * 64 + g]);
    float lr = p.in[21][(dd * 64 + g) * 64 + pp], li = p.in[22][(dd * 64 + g) * 64 + pp];
    float mag = __expf(lr * step), sn, cs; sincos_red(li * step, sn, cs);
    float ar = mag * cs, ai = mag * sn;
#pragma unroll
    for (int i = 0; i < 5; ++i) { float r2 = ar * ar - ai * ai, i2 = 2.f * ar * ai; ar = r2; ai = i2; }
    int c0 = seq_start(sq) >> 5, nc = seq_len(sq) >> 5;
    float cr = 0.f, ci = 0.f;
    int n = dd * 128 + pp;
    for (int j0 = 0; j0 < nc; j0 += 8) {
      float er[8], ei[8];
#pragma unroll
      for (int u = 0; u < 8; ++u) {
        int j = dd == 0 ? (j0 + u) : (nc - 1 - j0 - u);
        size_t o = ((size_t)g * 1536 + c0 + j) * 256 + n;
        er[u] = E[o]; ei[u] = E[o + 64];
      }
#pragma unroll
      for (int u = 0; u < 8; ++u) {
        int j = dd == 0 ? (j0 + u) : (nc - 1 - j0 - u);
        size_t o = ((size_t)g * 1536 + c0 + j) * 768 + 512 + n;
        us5[o] = (hf)cr; us5[o + 64] = (hf)ci;
        float nr = ar * cr - ai * ci + er[u], ni = ar * ci + ai * cr + ei[u]; cr = nr; ci = ni;
      }
    }
  }
}

__device__ __forceinline__ void norm_phase(const Params& p, int layer, int which, bool from_inputs) {
  const float* mod = (const float*)(p.ws + OFF_SMALL + SM_MOD) + (size_t)layer * 5 * 12288;
  const float* gain = (which == 0 ? p.in[6] : p.in[7]) + layer * 2048;
  hf* h16 = (hf*)(p.ws + OFF_RA);
  const int lane = tidx() & 63, gw = blockIdx.x * 4 + (tidx() >> 6), nw = gridDim.x * 4;
  const int o_sh = which == 0 ? 0 : 3 * 2048, o_sc = o_sh + 2048;
  for (int t = gw; t < T_TOK; t += nw) {
    const float* xr = from_inputs ? (t < 32768 ? p.in[0] + (size_t)t * 2048 : p.in[1] + (size_t)(t - 32768) * 2048) : p.out + (size_t)t * 2048;
    float4 v[8]; float ss = 0.f;
#pragma unroll
    for (int i = 0; i < 8; ++i) { v[i] = ((const float4*)xr)[i * 64 + lane]; ss += v[i].x * v[i].x + v[i].y * v[i].y + v[i].z * v[i].z + v[i].w * v[i].w; }
#pragma unroll
    for (int o = 32; o; o >>= 1) ss += shx(ss, o);
    float r = rsqrtf(ss * (1.f / 2048.f) + 1e-6f);
    const float* m = mod + (size_t)seq_of(t) * 12288;
#pragma unroll
    for (int i = 0; i < 8; ++i) {
      int idx = (i * 64 + lane) * 4;
      float4 g4 = *(const float4*)(gain + idx), sc = *(const float4*)(m + o_sc + idx), sh = *(const float4*)(m + o_sh + idx);
      h4 o;
      o[0] = (hf)(v[i].x * r * g4.x * (1.f + sc.x) + sh.x); o[1] = (hf)(v[i].y * r * g4.y * (1.f + sc.y) + sh.y);
      o[2] = (hf)(v[i].z * r * g4.z * (1.f + sc.z) + sh.z); o[3] = (hf)(v[i].w * r * g4.w * (1.f + sc.w) + sh.w);
      *(h4*)(h16 + (size_t)t * 2048 + idx) = o;
      if (from_inputs) *(float4*)(p.out + (size_t)t * 2048 + idx) = v[i];
    }
  }
}

__device__ __forceinline__ void final_norm(const Params& p) {
  const int lane = tidx() & 63, gw = blockIdx.x * 4 + (tidx() >> 6), nw = gridDim.x * 4;
  for (int t = gw; t < T_TOK; t += nw) {
    float* xr = p.out + (size_t)t * 2048;
    float4 v[8]; float ss = 0.f;
#pragma unroll
    for (int i = 0; i < 8; ++i) { v[i] = ((const float4*)xr)[i * 64 + lane]; ss += v[i].x * v[i].x + v[i].y * v[i].y + v[i].z * v[i].z + v[i].w * v[i].w; }
#pragma unroll
    for (int o = 32; o; o >>= 1) ss += shx(ss, o);
    float r = rsqrtf(ss * (1.f / 2048.f) + 1e-6f);
#pragma unroll
    for (int i = 0; i < 8; ++i) {
      int idx = (i * 64 + lane) * 4;
      float4 g4 = *(const float4*)(p.in[47] + idx);
      float4 o; o.x = v[i].x * r * g4.x; o.y = v[i].y * r * g4.y; o.z = v[i].z * r * g4.z; o.w = v[i].w * r * g4.w;
      *(float4*)(xr + idx) = o;
    }
  }
}

struct GemmArgs { const hf* A; size_t lda, sA; const hf* Bt; size_t ldb, sB; int M, N, K, nb; };

#define EPI_BEGIN _Pragma("unroll") for (int mi = 0; mi < 8; ++mi) _Pragma("unroll") for (int ni = 0; ni < 8; ++ni) { \
    const int row = row0 + mi * 16 + fr; const int c = col0 + ni * 16 + fq * 4; const f4 v = acc[mi][ni]; (void)row; (void)c; (void)b;
#define EPI_END __builtin_amdgcn_sched_barrier(0); }

constexpr int G_LD = 72;
constexpr int G_STAGE = 512 * G_LD;
constexpr int DYN_LDS = 2 * G_STAGE * 2;

template <class Epi>
__device__ __forceinline__ void gemm_run(const GemmArgs g, Epi epi, char* smem) {
  hf* sbase = (hf*)smem;
  const int tid = tidx(), lane = tid & 63, wv = tid >> 6, wm = wv >> 1, wn = wv & 1, fr = lane & 15, fq = lane >> 4;
  const int tm = g.M >> 8, tn = (g.N + 255) >> 8, per = tm * tn, total = per * g.nb, nk = g.K >> 6;
  const int lr = tid >> 3, lc = (tid & 7) * 8;
  for (int tile = blockIdx.x; tile < total; tile += gridDim.x) {
    int gidx = tile;
    if (gridDim.x == 256 && (tile | 255) < total) { const int s = tile & 255; gidx = (tile & ~255) + (s & 7) * 32 + (s >> 3); }
    const int b = gidx / per, r = gidx - b * per;
    const int band = r / (tm * 8), rbn = r - band * tm * 8, bw = min(8, tn - band * 8);
    const int mt = rbn / bw, nt = band * 8 + rbn - mt * bw;
    const hf* Ap = g.A + (size_t)b * g.sA + (size_t)(mt * 256 + lr) * g.lda + lc;
    const hf* Bp = g.Bt + (size_t)b * g.sB + (size_t)(nt * 256 + lr) * g.ldb + lc;
    u4 ra[8], rb[8];
    f4 acc[8][8];
#pragma unroll
    for (int i = 0; i < 8; ++i)
#pragma unroll
      for (int j = 0; j < 8; ++j) acc[i][j] = (f4){0.f, 0.f, 0.f, 0.f};
    __syncthreads();
#pragma unroll
    for (int i = 0; i < 8; ++i) { ra[i] = *(const u4*)(Ap + (size_t)(32 * i) * g.lda); rb[i] = *(const u4*)(Bp + (size_t)(32 * i) * g.ldb); }
#pragma unroll
    for (int i = 0; i < 8; ++i) { *(u4*)(sbase + (lr + 32 * i) * G_LD + lc) = ra[i]; *(u4*)(sbase + (256 + lr + 32 * i) * G_LD + lc) = rb[i]; }
    if (nk > 1) {
#pragma unroll
      for (int i = 0; i < 8; ++i) { ra[i] = *(const u4*)(Ap + (size_t)(32 * i) * g.lda + 64); rb[i] = *(const u4*)(Bp + (size_t)(32 * i) * g.ldb + 64); }
    }
    __syncthreads();
    for (int kt = 0; kt < nk; ++kt) {
      if (kt + 1 < nk) {
        hf* st = sbase + ((kt + 1) & 1) * G_STAGE;
#pragma unroll
        for (int i = 0; i < 8; ++i) { *(u4*)(st + (lr + 32 * i) * G_LD + lc) = ra[i]; *(u4*)(st + (256 + lr + 32 * i) * G_LD + lc) = rb[i]; }
      }
      if (kt + 2 < nk) {
        const int ko = (kt + 2) * 64;
#pragma unroll
        for (int i = 0; i < 8; ++i) { ra[i] = *(const u4*)(Ap + (size_t)(32 * i) * g.lda + ko); rb[i] = *(const u4*)(Bp + (size_t)(32 * i) * g.ldb + ko); }
      }
      __builtin_amdgcn_sched_barrier(0);
      const hf* sA = sbase + (kt & 1) * G_STAGE + (wm * 128 + fr) * G_LD + fq * 8;
      const hf* sB = sbase + (kt & 1) * G_STAGE + (256 + wn * 128 + fr) * G_LD + fq * 8;
#pragma unroll
      for (int ks = 0; ks < 2; ++ks) {
        h8 af[8];
#pragma unroll
        for (int i = 0; i < 8; ++i) af[i] = *(const h8*)(sA + i * 16 * G_LD + ks * 32);
#pragma unroll
        for (int nh = 0; nh < 2; ++nh) {
          h8 bf[4];
#pragma unroll
          for (int i = 0; i < 4; ++i) bf[i] = *(const h8*)(sB + (nh * 4 + i) * 16 * G_LD + ks * 32);
#pragma unroll
          for (int mi = 0; mi < 8; ++mi)
#pragma unroll
            for (int ni = 0; ni < 4; ++ni) acc[mi][nh * 4 + ni] = mfma16(bf[ni], af[mi], acc[mi][nh * 4 + ni]);
          __builtin_amdgcn_sched_barrier(0);
        }
      }
      __syncthreads();
    }
    epi(acc, b, mt * 256 + wm * 128, nt * 256 + wn * 128, fr, fq);
  }
}

struct EpiInproj0 { hf* prw; hf* us5;
  DI void operator()(f4 (&acc)[8][8], int b, int row0, int col0, int fr, int fq) const {
    EPI_BEGIN
      if (c < 3456) *(h4*)(prw + (size_t)row * 3456 + c) = cvt4(v);
      else if (c < 4480) { int cu = c - 3456, g = cu >> 4, cc = cu & 15; *(h4*)(us5 + ((size_t)g * 1536 + (row >> 5)) * 768 + (row & 31) * 16 + cc) = cvt4(v); }
    EPI_END } };
struct EpiS5p1 { float* E;
  DI void operator()(f4 (&acc)[8][8], int b, int row0, int col0, int fr, int fq) const {
    EPI_BEGIN
      *(f4*)(E + ((size_t)b * 1536 + row) * 256 + c) = v;
    EPI_END } };
struct EpiS5p2 { hf* z16;
  DI void operator()(f4 (&acc)[8][8], int b, int row0, int col0, int fr, int fq) const {
    EPI_BEGIN
      int tok = row * 32 + (c >> 4), cc = c & 15; h4 o;
#pragma unroll
      for (int j = 0; j < 4; ++j) { float y = v[j] * (1.f / 256.f); float u = 0.7978845608f * (y + 0.044715f * y * y * y); float th = 1.f - 2.f / (1.f + __expf(2.f * u)); o[j] = (hf)(0.5f * y * (1.f + th)); }
      *(h4*)(z16 + (size_t)tok * 1024 + b * 16 + cc) = o;
    EPI_END } };
struct EpiGlu { const hf* z16; const float* bglu; hf* mix;
  DI void operator()(f4 (&acc)[8][8], int b, int row0, int col0, int fr, int fq) const {
    EPI_BEGIN
      h4 z = *(const h4*)(z16 + (size_t)row * 1024 + c); f4 bb = *(const f4*)(bglu + c); h4 o;
#pragma unroll
      for (int j = 0; j < 4; ++j) o[j] = (hf)((float)z[j] * sigmoidf_(v[j] + bb[j]));
      *(h4*)(mix + (size_t)row * 2048 + 1024 + c) = o;
    EPI_END } };
struct EpiStore { hf* dst; size_t ld;
  DI void operator()(f4 (&acc)[8][8], int b, int row0, int col0, int fr, int fq) const {
    EPI_BEGIN
      *(h4*)(dst + (size_t)row * ld + c) = cvt4(v);
    EPI_END } };
struct EpiResid { float* x; const float* gate; int tok0;
  DI void operator()(f4 (&acc)[8][8], int b, int row0, int col0, int fr, int fq) const {
    EPI_BEGIN
      int tok = tok0 + row; const float* gp = gate + (size_t)seq_of(tok) * 12288 + c; f4 gg = *(const f4*)gp;
      f4* xp = (f4*)(x + (size_t)tok * 2048 + c); f4 xv = *xp;
      xv[0] += gg[0] * v[0]; xv[1] += gg[1] * v[1]; xv[2] += gg[2] * v[2]; xv[3] += gg[3] * v[3]; *xp = xv;
    EPI_END } };
struct EpiInproj1 { hf* p1; hf* vtd;
  DI void operator()(f4 (&acc)[8][8], int b, int row0, int col0, int fr, int fq) const {
    EPI_BEGIN
      if (c < 2848) *(h4*)(p1 + (size_t)row * 2848 + c) = cvt4(v);
      else if (c < 3872) { int cd = c - 2848;
#pragma unroll
        for (int j = 0; j < 4; ++j) vtd[(size_t)(cd + j) * T_TOK + row] = (hf)v[j]; }
    EPI_END } };
struct EpiUkv { hf* km; hf* vtm;
  DI void operator()(f4 (&acc)[8][8], int b, int row0, int col0, int fr, int fq) const {
    EPI_BEGIN
      int head = c / 192, d = c - head * 192;
      if (d < 64) *(h4*)(km + ((size_t)row * 8 + head) * 96 + d) = cvt4(v);
      else {
#pragma unroll
        for (int j = 0; j < 4; ++j) vtm[(size_t)(head * 128 + d - 64 + j) * T_TOK + row] = (hf)v[j]; }
    EPI_END } };

typedef float f2 __attribute__((ext_vector_type(2)));
constexpr int RV_TS = 324;
template <int RPL>
__device__ __forceinline__ void rwkv_item(const Params& p, int seq, int head, int dir, int slab, char* smem) {
  float* sVec = (float*)smem;
  float* sV = sVec + 32 * RV_TS;
  hf* sTw = (hf*)(sV + 32 * 64);
  hf* sDa = sTw + 32 * 72;
  float* sBon = (float*)(sDa + 32 * 72);
  const int tid = tidx(), lane = tid & 63, wv = tid >> 6, fr = lane & 15, fq = lane >> 4;
  const int L = seq_len(seq), s0 = seq_start(seq);
  const hf* P = (const hf*)(p.ws + OFF_RB);
  hf* yout = (hf*)(p.ws + OFF_RA) + (size_t)dir * T_TOK * 1024;
  float* bonus = (float*)(p.ws + OFF_SMALL + SM_BONUS);
  const float* mu = p.in[10];
  const int chg = head * 64 + wv * 16 + fr;
  h8 wf[2], af2[2];
#pragma unroll
  for (int ks = 0; ks < 2; ++ks)
#pragma unroll
    for (int e = 0; e < 8; ++e) {
      int r = ks * 32 + fq * 8 + e;
      wf[ks][e] = (hf)p.in[12][(size_t)(dir * 64 + r) * 1024 + chg];
      af2[ks][e] = (hf)p.in[14][(size_t)(dir * 64 + r) * 1024 + chg];
    }
  const float c_w0 = p.in[11][dir * 1024 + chg], c_a0 = p.in[13][dir * 1024 + chg], c_ka = p.in[17][chg], c_rk = p.in[18][chg];
  const int li_t = tid >> 3, part = tid & 7;
  int gcol[5] = {head * 64 + part * 8, 1024 + head * 64 + part * 8, 2048 + head * 64 + part * 8, 3072 + dir * 64 + part * 8, 3200 + dir * 64 + part * 8};
  u4 raw[5][3];
  const int nch = L >> 5;
  auto load_raw = [&](int c) {
    int t0 = dir ? L - 32 * (c + 1) : 32 * c; int tl = t0 + li_t;
#pragma unroll
    for (int g = 0; g < 5; ++g)
#pragma unroll
      for (int n = 0; n < 3; ++n) {
        int tt = tl + n - 1;
        raw[g][n] = (tt >= 0 && tt < L) ? *(const u4*)(P + (size_t)(s0 + tt) * 3456 + gcol[g]) : (u4){0u, 0u, 0u, 0u};
      }
  };
  f2 S01[RPL], S23[RPL];
#pragma unroll
  for (int r = 0; r < RPL; ++r) { S01[r] = (f2){0.f, 0.f}; S23[r] = (f2){0.f, 0.f}; }
  const int ks_ = tid & 15, rg = tid >> 4, rbase = slab * (16 * RPL) + rg * RPL;
  load_raw(0);
  for (int c = 0; c < nch; ++c) {
    const int t0 = dir ? L - 32 * (c + 1) : 32 * c;
    __syncthreads();
#pragma unroll
    for (int g = 0; g < 5; ++g) {
      h8 pv = __builtin_bit_cast(h8, raw[g][0]), cv = __builtin_bit_cast(h8, raw[g][1]), nv = __builtin_bit_cast(h8, raw[g][2]);
      float mx[8];
      const f4 m0 = *(const f4*)(mu + gcol[g]), m1 = *(const f4*)(mu + gcol[g] + 4);
#pragma unroll
      for (int e = 0; e < 8; ++e) { float cu = (float)cv[e]; float mm = e < 4 ? m0[e & 3] : m1[e & 3]; mx[e] = cu + mm * (0.5f * ((float)pv[e] + (float)nv[e]) - cu); }
      float* vb = sVec + li_t * RV_TS + part * 8;
      if (g == 0) {
        *(f4*)(vb + 256) = (f4){mx[0], mx[1], mx[2], mx[3]}; *(f4*)(vb + 260) = (f4){mx[4], mx[5], mx[6], mx[7]};
      } else if (g == 1) {
        const f4 k0 = *(const f4*)(p.in[16] + head * 64 + part * 8), k1 = *(const f4*)(p.in[16] + head * 64 + part * 8 + 4);
        float kkv[8], ss = 0.f;
#pragma unroll
        for (int e = 0; e < 8; ++e) { kkv[e] = mx[e] * (e < 4 ? k0[e & 3] : k1[e & 3]); ss += kkv[e] * kkv[e]; }
        *(f4*)(vb + 192) = (f4){mx[0], mx[1], mx[2], mx[3]}; *(f4*)(vb + 196) = (f4){mx[4], mx[5], mx[6], mx[7]};
        ss += shx(ss, 1); ss += shx(ss, 2); ss += shx(ss, 4);
        float inv = 1.f / fmaxf(sqrtf(ss), 1e-12f);
        *(f4*)(vb + 64) = (f4){kkv[0] * inv, kkv[1] * inv, kkv[2] * inv, kkv[3] * inv};
        *(f4*)(vb + 68) = (f4){kkv[4] * inv, kkv[5] * inv, kkv[6] * inv, kkv[7] * inv};
      } else if (g == 2) {
        *(f4*)(sV + li_t * 64 + part * 8) = (f4){mx[0], mx[1], mx[2], mx[3]}; *(f4*)(sV + li_t * 64 + part * 8 + 4) = (f4){mx[4], mx[5], mx[6], mx[7]};
      } else if (g == 3) {
        h8 o;
#pragma unroll
        for (int e = 0; e < 8; ++e) o[e] = (hf)(1.f - 2.f / (1.f + __expf(2.f * mx[e])));
        *(h8*)(sTw + li_t * 72 + part * 8) = o;
      } else {
        h8 o;
#pragma unroll
        for (int e = 0; e < 8; ++e) o[e] = (hf)mx[e];
        *(h8*)(sDa + li_t * 72 + part * 8) = o;
      }
    }
    if (tid < 32) sBon[tid] = 0.f;
    __syncthreads();
    if (c + 1 < nch) load_raw(c + 1);
#pragma unroll
    for (int mt = 0; mt < 2; ++mt) {
      f4 accw = {0.f, 0.f, 0.f, 0.f}, acca = {0.f, 0.f, 0.f, 0.f};
#pragma unroll
      for (int ks = 0; ks < 2; ++ks) {
        h8 a1 = *(const h8*)(sTw + (mt * 16 + fr) * 72 + ks * 32 + fq * 8);
        h8 a2 = *(const h8*)(sDa + (mt * 16 + fr) * 72 + ks * 32 + fq * 8);
        accw = mfma16(a1, wf[ks], accw); acca = mfma16(a2, af2[ks], acca);
      }
      const int ch = wv * 16 + fr;
#pragma unroll
      for (int j = 0; j < 4; ++j) {
        int l2 = mt * 16 + fq * 4 + j;
        float* vb = sVec + l2 * RV_TS + ch;
        float dec = __expf(-0.6065306597f * sigmoidf_(c_w0 + accw[j]));
        float icl = sigmoidf_(c_a0 + acca[j]);
        float kx = vb[192], kkv = vb[64];
        float kd = kx * (1.f + (icl - 1.f) * c_ka);
        vb[0] = dec; vb[128] = icl * kkv; vb[192] = kd;
        if (slab == 0) {
          float bon = allred16(vb[256] * kd * c_rk);
          if (fr == 0) atomicAdd(&sBon[l2], bon);
        }
      }
    }
    __syncthreads();
    if (slab == 0 && tid < 32) bonus[((size_t)(s0 + t0 + tid) * 16 + head) * 2 + dir] = sBon[tid];
#pragma unroll 4
    for (int i = 0; i < 32; ++i) {
      const int li = dir ? 31 - i : i;
      const float* base = sVec + li * RV_TS + ks_ * 4;
      const f4 w4 = *(const f4*)(base), kk4 = *(const f4*)(base + 64), b4 = *(const f4*)(base + 128),
               kd4 = *(const f4*)(base + 192), r4 = *(const f4*)(base + 256);
      const f2 w01 = {w4[0], w4[1]}, w23 = {w4[2], w4[3]}, kk01 = {kk4[0], kk4[1]}, kk23 = {kk4[2], kk4[3]};
      const f2 b01 = {b4[0], b4[1]}, b23 = {b4[2], b4[3]}, kd01 = {kd4[0], kd4[1]}, kd23 = {kd4[2], kd4[3]};
      const f2 r01 = {r4[0], r4[1]}, r23 = {r4[2], r4[3]};
      float vv[RPL], yv[RPL];
      if (RPL == 4) { const f4 v4 = *(const f4*)(sV + li * 64 + rbase); vv[0] = v4[0]; vv[1 % RPL] = v4[1]; vv[2 % RPL] = v4[2]; vv[3 % RPL] = v4[3]; }
      else {
#pragma unroll
        for (int r = 0; r < RPL; ++r) vv[r] = sV[li * 64 + rbase + r];
      }
#pragma unroll
      for (int r = 0; r < RPL; ++r) {
        f2 t = S01[r] * kk01; t = S23[r] * kk23 + t;
        const float sa = allred16(t[0] + t[1]);
        const f2 nsa = {-sa, -sa}, v2 = {vv[r], vv[r]};
        S01[r] = v2 * kd01 + (nsa * b01 + S01[r] * w01);
        S23[r] = v2 * kd23 + (nsa * b23 + S23[r] * w23);
        f2 u = S01[r] * r01; u = S23[r] * r23 + u;
        yv[r] = allred16(u[0] + u[1]);
      }
      if (ks_ == 0) {
        hf* yp = yout + (size_t)(s0 + t0 + li) * 1024 + head * 64 + rbase;
        if (RPL == 4) { h4 o; o[0] = (hf)yv[0]; o[1] = (hf)yv[1 % RPL]; o[2] = (hf)yv[2 % RPL]; o[3] = (hf)yv[3 % RPL]; *(h4*)yp = o; }
        else {
#pragma unroll
          for (int r = 0; r < RPL; ++r) yp[r] = (hf)yv[r];
        }
      }
    }
  }
}

__device__ __forceinline__ void rwkv_scan_phase(const Params& p, char* smem) {
  for (int item = blockIdx.x; item < 256; item += gridDim.x) {
    if (item < 128) rwkv_item<1>(p, 4, item >> 3, (item >> 2) & 1, item & 3, smem);
    else { int it = item - 128; rwkv_item<4>(p, it >> 5, (it >> 1) & 15, it & 1, 0, smem); }
  }
}

__device__ __forceinline__ void gate_prep(const Params& p) {
  const hf* P = (const hf*)(p.ws + OFF_RB);
  hf* sg = (hf*)(p.ws + OFF_US5 + 96 * MiB);
  const float* mu = p.in[10];
  for (int idx = blockIdx.x * 256 + tidx(); idx < T_TOK * 16; idx += gridDim.x * 256) {
    int t = idx >> 4, part = idx & 15, col = 3328 + part * 8;
    int sq = seq_of(t), pos = t - seq_start(sq), L = seq_len(sq);
    h8 cv = *(const h8*)(P + (size_t)t * 3456 + col), pv, nv;
    for (int e = 0; e < 8; ++e) { pv[e] = (hf)0; nv[e] = (hf)0; }
    if (pos > 0) pv = *(const h8*)(P + (size_t)(t - 1) * 3456 + col);
    if (pos < L - 1) nv = *(const h8*)(P + (size_t)(t + 1) * 3456 + col);
    h8 o;
#pragma unroll
    for (int e = 0; e < 8; ++e) { float cu = (float)cv[e]; float mx = cu + mu[col + e] * (0.5f * ((float)pv[e] + (float)nv[e]) - cu); o[e] = (hf)sigmoidf_(mx); }
    *(h8*)(sg + (size_t)t * 128 + part * 8) = o;
  }
}

__device__ __forceinline__ void rwkv_post(const Params& p) {
  const hf* P = (const hf*)(p.ws + OFF_RB);
  const hf* y0 = (const hf*)(p.ws + OFF_RA); const hf* y1 = y0 + (size_t)T_TOK * 1024;
  const hf* g16 = (const hf*)(p.ws + OFF_US5);
  const float* bonus = (const float*)(p.ws + OFF_SMALL + SM_BONUS);
  hf* mix = (hf*)(p.ws + OFF_MIX0);
  const float* mu = p.in[10];
  const int lane = tidx() & 63, gw = blockIdx.x * 4 + (tidx() >> 6), nw = gridDim.x * 4;
  for (int t = gw; t < T_TOK; t += nw) {
    int sq = seq_of(t), pos = t - seq_start(sq), L = seq_len(sq);
    int ch0 = lane * 16, head = lane >> 2;
    float y[16]; float sum = 0.f;
#pragma unroll
    for (int q = 0; q < 2; ++q) {
      h8 a = *(const h8*)(y0 + (size_t)t * 1024 + ch0 + q * 8), bq = *(const h8*)(y1 + (size_t)t * 1024 + ch0 + q * 8);
#pragma unroll
      for (int e = 0; e < 8; ++e) { y[q * 8 + e] = (float)a[e] + (float)bq[e]; sum += y[q * 8 + e]; }
    }
    sum += shx(sum, 1); sum += shx(sum, 2);
    float mean = sum * (1.f / 64.f), var = 0.f;
#pragma unroll
    for (int e = 0; e < 16; ++e) { float dd = y[e] - mean; var += dd * dd; }
    var += shx(var, 1); var += shx(var, 2);
    float rs = rsqrtf(var * (1.f / 64.f) + 64e-5f);
    float bon = bonus[((size_t)t * 16 + head) * 2] + bonus[((size_t)t * 16 + head) * 2 + 1];
#pragma unroll
    for (int q = 0; q < 2; ++q) {
      int col = 2048 + ch0 + q * 8;
      h8 cv = *(const h8*)(P + (size_t)t * 3456 + col), pv, nv;
      for (int e = 0; e < 8; ++e) { pv[e] = (hf)0; nv[e] = (hf)0; }
      if (pos > 0) pv = *(const h8*)(P + (size_t)(t - 1) * 3456 + col);
      if (pos < L - 1) nv = *(const h8*)(P + (size_t)(t + 1) * 3456 + col);
      h8 gg = *(const h8*)(g16 + (size_t)t * 1024 + ch0 + q * 8), o;
#pragma unroll
      for (int e = 0; e < 8; ++e) {
        int ch = ch0 + q * 8 + e;
        float cu = (float)cv[e]; float vm = cu + mu[col + e] * (0.5f * ((float)pv[e] + (float)nv[e]) - cu);
        float yn = (y[q * 8 + e] - mean) * rs * p.in[19][ch] + p.in[20][ch] + bon * vm;
        o[e] = (hf)(yn * (float)gg[e]);
      }
      *(h8*)(mix + (size_t)t * 2048 + ch0 + q * 8) = o;
    }
  }
}

__device__ __forceinline__ void convact_phase(const Params& p, int layer, int slab) {
  const hf* U = (const hf*)(p.ws + OFF_RB); hf* act = (hf*)(p.ws + OFF_ACT);
  const float* cw = p.in[44] + (size_t)layer * 3 * 11264; const float* cb = p.in[45] + (size_t)layer * 11264;
  const int lmask = slab == 2 ? 16383 : 8191;
  for (int idx = blockIdx.x * 256 + tidx(); idx < 16384 * 704; idx += gridDim.x * 256) {
    int row = idx / 704, f0 = (idx - row * 704) * 8, pos = row & lmask;
    bool hp = pos > 0, hn = pos < lmask;
    float res[2][8];
#pragma unroll
    for (int hh = 0; hh < 2; ++hh) {
      int col = f0 + hh * 5632;
      h8 cv = *(const h8*)(U + (size_t)row * 11264 + col), pv, nv;
      for (int e = 0; e < 8; ++e) { pv[e] = (hf)0; nv[e] = (hf)0; }
      if (hp) pv = *(const h8*)(U + (size_t)(row - 1) * 11264 + col);
      if (hn) nv = *(const h8*)(U + (size_t)(row + 1) * 11264 + col);
#pragma unroll
      for (int e = 0; e < 8; ++e)
        res[hh][e] = (float)pv[e] * cw[col + e] + (float)cv[e] * cw[11264 + col + e] + (float)nv[e] * cw[22528 + col + e] + cb[col + e];
    }
    h8 o;
#pragma unroll
    for (int e = 0; e < 8; ++e) { float gt = res[1][e]; o[e] = (hf)(gt * sigmoidf_(gt) * res[0][e]); }
    *(h8*)(act + (size_t)row * 5632 + f0) = o;
  }
}

__device__ __forceinline__ void mla_prep(const Params& p) {
  const hf* p1 = (const hf*)(p.ws + OFF_RB);
  hf* cqn = (hf*)(p.ws + OFF_MIX1); hf* ckvn = (hf*)(p.ws + OFF_MIX1 + 48 * MiB);
  hf* km = (hf*)(p.ws + OFF_RA + 72 * MiB);
  const int lane = tidx() & 63, gw = blockIdx.x * 4 + (tidx() >> 6), nw = gridDim.x * 4;
  if (blockIdx.x == 0 && tidx() == 0) {
    float s1 = 0.f, s2 = 0.f;
    for (int i = 0; i < 64; ++i) { s1 += p.in[37][i] * p.in[38][i]; s2 += p.in[39][i] * p.in[40][i]; }
    float* lamp = (float*)(p.ws + OFF_SMALL + SM_CNT) + 8;
    lamp[0] = __expf(s1) - __expf(s2) + 0.35550906759f;
  }
  for (int t = gw; t < T_TOK; t += nw) {
    const hf* row = p1 + (size_t)t * 2848;
    h8 a = *(const h8*)(row + lane * 8); float ss = 0.f;
#pragma unroll
    for (int e = 0; e < 8; ++e) ss += (float)a[e] * (float)a[e];
#pragma unroll
    for (int o = 32; o; o >>= 1) ss += shx(ss, o);
    float r = rsqrtf(ss * (1.f / 512.f) + 1e-6f); h8 o8;
#pragma unroll
    for (int e = 0; e < 8; ++e) o8[e] = (hf)((float)a[e] * r * p.in[33][lane * 8 + e]);
    *(h8*)(cqn + (size_t)t * 512 + lane * 8) = o8;
    h4 b4 = *(const h4*)(row + 512 + lane * 4); float s2 = 0.f;
#pragma unroll
    for (int e = 0; e < 4; ++e) s2 += (float)b4[e] * (float)b4[e];
#pragma unroll
    for (int o = 32; o; o >>= 1) s2 += shx(s2, o);
    float r2 = rsqrtf(s2 * (1.f / 256.f) + 1e-6f); h4 o4;
#pragma unroll
    for (int e = 0; e < 4; ++e) o4[e] = (hf)((float)b4[e] * r2 * p.in[34][lane * 4 + e]);
    *(h4*)(ckvn + (size_t)t * 256 + lane * 4) = o4;
    if (lane < 16) {
      int pos = t - seq_start(seq_of(t));
      float inv = exp2f(-(float)lane * 0.830482023721841f);
      float sn, cs; sincos_red((float)pos * inv, sn, cs);
      float x1 = (float)row[768 + lane], x2 = (float)row[784 + lane];
      hf o1 = (hf)(x1 * cs - x2 * sn), o2 = (hf)(x1 * sn + x2 * cs);
#pragma unroll
      for (int h = 0; h < 8; ++h) { km[((size_t)t * 8 + h) * 96 + 64 + lane] = o1; km[((size_t)t * 8 + h) * 96 + 80 + lane] = o2; }
    }
  }
}

__device__ __forceinline__ void q_rope(const Params& p) {
  hf* qm = (hf*)(p.ws + OFF_RA);
  for (int idx = blockIdx.x * 256 + tidx(); idx < T_TOK * 128; idx += gridDim.x * 256) {
    int t = idx >> 7, h = (idx >> 4) & 7, i = idx & 15;
    int pos = t - seq_start(seq_of(t));
    float inv = exp2f(-(float)i * 0.830482023721841f);
    float sn, cs; sincos_red((float)pos * inv, sn, cs);
    hf* a = qm + ((size_t)t * 8 + h) * 96 + 64 + i;
    float x1 = (float)a[0], x2 = (float)a[16];
    a[0] = (hf)(x1 * cs - x2 * sn); a[16] = (hf)(x1 * sn + x2 * cs);
  }
}

constexpr int A_STG = 64 * 104 + 128 * 72;
template <int DQK, bool BIAS>
__device__ __forceinline__ void attn_pass(const hf* __restrict__ Q, int ldq, const hf* __restrict__ Kp, int ldk, const hf* __restrict__ VT,
                                          int s0, int L, int q0, float scale_l2, const float* sBias, f4 (&oacc)[8][4], char* smem) {
  constexpr int KS = DQK + 8, NKS = DQK / 32, NKL = DQK / 32;
  hf* sbase = (hf*)smem;
  const int tid = tidx(), lane = tid & 63, wv = tid >> 6, fr = lane & 15, fq = lane >> 4;
  h8 qf[4][NKS];
#pragma unroll
  for (int nq = 0; nq < 4; ++nq)
#pragma unroll
    for (int ks = 0; ks < NKS; ++ks) qf[nq][ks] = *(const h8*)(Q + (size_t)(s0 + q0 + wv * 64 + nq * 16 + fr) * ldq + ks * 32 + fq * 8);
  float mrun[4], lrun[4];
#pragma unroll
  for (int nq = 0; nq < 4; ++nq) { mrun[nq] = -1e30f; lrun[nq] = 0.f; }
#pragma unroll
  for (int md = 0; md < 8; ++md)
#pragma unroll
    for (int nq = 0; nq < 4; ++nq) oacc[md][nq] = (f4){0.f, 0.f, 0.f, 0.f};
  u4 rk[NKL], rv[4];
  auto loadKV = [&](int kt) {
    const int key0 = kt * 64;
#pragma unroll
    for (int i = 0; i < NKL; ++i) rk[i] = *(const u4*)(Kp + (size_t)(s0 + key0 + (tid >> 2)) * ldk + ((tid & 3) + 4 * i) * 8);
#pragma unroll
    for (int i = 0; i < 4; ++i) { int idx = tid + 256 * i, dv = idx >> 3, ch = idx & 7; rv[i] = *(const u4*)(VT + (size_t)dv * T_TOK + s0 + key0 + ch * 8); }
  };
  auto storeKV = [&](int st) {
    hf* sK = sbase + st * A_STG; hf* sVT = sK + 64 * 104;
#pragma unroll
    for (int i = 0; i < NKL; ++i) *(u4*)(sK + (tid >> 2) * KS + ((tid & 3) + 4 * i) * 8) = rk[i];
#pragma unroll
    for (int i = 0; i < 4; ++i) { int idx = tid + 256 * i, dv = idx >> 3, ch = idx & 7; *(u4*)(sVT + dv * 72 + ch * 8) = rv[i]; }
  };
  const int nkt = L >> 6;
  __syncthreads();
  loadKV(0); storeKV(0);
  if (nkt > 1) loadKV(1);
  __syncthreads();
  for (int kt = 0; kt < nkt; ++kt) {
    if (kt + 1 < nkt) storeKV((kt + 1) & 1);
    if (kt + 2 < nkt) loadKV(kt + 2);
    const hf* sK = sbase + (kt & 1) * A_STG; const hf* sVT = sK + 64 * 104;
    f4 sacc[4][4];
#pragma unroll
    for (int mk = 0; mk < 4; ++mk) {
      h8 kf[NKS];
#pragma unroll
      for (int ks = 0; ks < NKS; ++ks) kf[ks] = *(const h8*)(sK + (mk * 16 + fr) * KS + ks * 32 + fq * 8);
#pragma unroll
      for (int nq = 0; nq < 4; ++nq) {
        f4 a = {0.f, 0.f, 0.f, 0.f};
#pragma unroll
        for (int ks = 0; ks < NKS; ++ks) a = mfma16(kf[ks], qf[nq][ks], a);
        sacc[mk][nq] = a;
      }
    }
    h8 pf[4][2];
    const int key0 = kt * 64;
    bool uni = true; float add = 0.f;
    if (BIAS) {
      const int dmin = key0 - (q0 + 255), dmax = key0 + 63 - q0;
      uni = (dmax <= -91) || (dmin >= 91);
      add = dmax <= -91 ? sBias[0] : sBias[256];
    }
#pragma unroll
    for (int nq = 0; nq < 4; ++nq) {
      if (BIAS) {
        if (uni) {
#pragma unroll
          for (int mk = 0; mk < 4; ++mk)
#pragma unroll
            for (int j = 0; j < 4; ++j) sacc[mk][nq][j] = sacc[mk][nq][j] * scale_l2 + add;
        } else {
#pragma unroll
          for (int mk = 0; mk < 4; ++mk)
#pragma unroll
            for (int j = 0; j < 4; ++j) {
              int rel = (key0 + mk * 16 + fq * 4 + j) - (q0 + wv * 64 + nq * 16 + fr);
              rel = min(max(rel, -128), 128);
              sacc[mk][nq][j] = sacc[mk][nq][j] * scale_l2 + sBias[rel + 128];
            }
        }
      }
      float mx = -1e30f;
#pragma unroll
      for (int mk = 0; mk < 4; ++mk) mx = fmaxf(mx, fmaxf(fmaxf(sacc[mk][nq][0], sacc[mk][nq][1]), fmaxf(sacc[mk][nq][2], sacc[mk][nq][3])));
      mx = fmaxf(mx, shx(mx, 16)); mx = fmaxf(mx, shx(mx, 32));
      if (!BIAS) mx *= scale_l2;
      const bool upd = mx > mrun[nq] + 8.f;
      const float mnew = upd ? mx : mrun[nq];
      if (__builtin_amdgcn_ballot_w64(upd) != 0) {
        const float alpha = __builtin_amdgcn_exp2f(mrun[nq] - mnew);
        lrun[nq] *= alpha;
#pragma unroll
        for (int md = 0; md < 8; ++md) { oacc[md][nq][0] *= alpha; oacc[md][nq][1] *= alpha; oacc[md][nq][2] *= alpha; oacc[md][nq][3] *= alpha; }
      }
      mrun[nq] = mnew;
      float ps = 0.f;
#pragma unroll
      for (int mk = 0; mk < 4; ++mk)
#pragma unroll
        for (int j = 0; j < 4; ++j) {
          float pe = BIAS ? __builtin_amdgcn_exp2f(sacc[mk][nq][j] - mnew) : __builtin_amdgcn_exp2f(sacc[mk][nq][j] * scale_l2 - mnew);
          sacc[mk][nq][j] = pe; ps += pe;
        }
      lrun[nq] += ps;
#pragma unroll
      for (int s2 = 0; s2 < 2; ++s2)
#pragma unroll
        for (int i = 0; i < 8; ++i) pf[nq][s2][i] = (hf)sacc[2 * s2 + (i >> 2)][nq][i & 3];
    }
#pragma unroll
    for (int mh = 0; mh < 2; ++mh) {
      h8 vf[4][2];
#pragma unroll
      for (int m4 = 0; m4 < 4; ++m4)
#pragma unroll
        for (int s2 = 0; s2 < 2; ++s2) {
          h4 v0 = *(const h4*)(sVT + ((mh * 4 + m4) * 16 + fr) * 72 + s2 * 32 + fq * 4);
          h4 v1 = *(const h4*)(sVT + ((mh * 4 + m4) * 16 + fr) * 72 + s2 * 32 + 16 + fq * 4);
          vf[m4][s2] = __builtin_shufflevector(v0, v1, 0, 1, 2, 3, 4, 5, 6, 7);
        }
#pragma unroll
      for (int nq = 0; nq < 4; ++nq)
#pragma unroll
        for (int m4 = 0; m4 < 4; ++m4) {
          oacc[mh * 4 + m4][nq] = mfma16(vf[m4][0], pf[nq][0], oacc[mh * 4 + m4][nq]);
          oacc[mh * 4 + m4][nq] = mfma16(vf[m4][1], pf[nq][1], oacc[mh * 4 + m4][nq]);
        }
    }
    __syncthreads();
  }
#pragma unroll
  for (int nq = 0; nq < 4; ++nq) {
    float lt = lrun[nq]; lt += shx(lt, 16); lt += shx(lt, 32);
    const float inv = 1.f / lt;
#pragma unroll
    for (int md = 0; md < 8; ++md) { oacc[md][nq][0] *= inv; oacc[md][nq][1] *= inv; oacc[md][nq][2] *= inv; oacc[md][nq][3] *= inv; }
  }
}

__device__ __forceinline__ void attn_phase(const Params& p, char* smem, int coff) {
  __shared__ int sItem;
  int* counter = (int*)(p.ws + OFF_SMALL + SM_CNT) + coff;
  const float lam = ((const float*)(p.ws + OFF_SMALL + SM_CNT))[8];
  float* sBias = (float*)(smem + 2 * A_STG * 2);
  const hf* p1 = (const hf*)(p.ws + OFF_RB);
  const hf* vtd = (const hf*)(p.ws + OFF_VTD); const hf* vtm = (const hf*)(p.ws + OFF_VTM);
  const hf* qm = (const hf*)(p.ws + OFF_RA); const hf* km = (const hf*)(p.ws + OFF_RA + 72 * MiB);
  hf* mix = (hf*)(p.ws + OFF_MIX1);
  const int tid = tidx(), lane = tid & 63, wv = tid >> 6, fr = lane & 15, fq = lane >> 4;
  while (true) {
    __syncthreads();
    if (tid == 0) sItem = atomicAdd(counter, 1);
    __syncthreads();
    const int item = sItem;
    if (item >= 1536) break;
    int seq, h, qt;
    if (item < 512) { seq = 4; h = item >> 6; qt = item & 63; }
    else { int it = item - 512; seq = it >> 8; h = (it >> 5) & 7; qt = it & 31; }
    const int s0 = seq_start(seq), L = seq_len(seq), q0 = qt * 256;
    for (int i = tid; i < 257; i += 256) {
      int rel = i - 128, n = rel < 0 ? -rel : rel;
      int bk = n < 8 ? n : (n < 12 ? 8 : n < 16 ? 9 : n < 23 ? 10 : n < 32 ? 11 : n < 46 ? 12 : n < 64 ? 13 : n < 91 ? 14 : 15);
      if (rel > 0) bk += 16;
      sBias[i] = p.in[42][bk * 8 + h] * 1.44269504089f;
    }
#pragma unroll 1
    for (int m = 0; m < 2; ++m) {
      f4 oacc[8][4];
      attn_pass<64, true>(p1 + 800 + h * 128 + m * 64, 2848, p1 + 1824 + h * 128 + m * 64, 2848, vtd + (size_t)h * 128 * T_TOK, s0, L, q0,
                          0.125f * 1.44269504089f, sBias, oacc, smem);
      if (m == 0) {
#pragma unroll
        for (int nq = 0; nq < 4; ++nq)
#pragma unroll
          for (int md = 0; md < 8; ++md)
            *(h4*)(mix + (size_t)(s0 + q0 + wv * 64 + nq * 16 + fr) * 2048 + 1024 + h * 128 + md * 16 + fq * 4) = cvt4(oacc[md][nq]);
      } else {
#pragma unroll
        for (int nq = 0; nq < 4; ++nq) {
          hf* dst = mix + (size_t)(s0 + q0 + wv * 64 + nq * 16 + fr) * 2048 + 1024 + h * 128 + fq * 4;
          float ss = 0.f;
#pragma unroll
          for (int md = 0; md < 8; ++md) {
            h4 o0 = *(const h4*)(dst + md * 16);
#pragma unroll
            for (int j = 0; j < 4; ++j) { float o = (float)o0[j] - lam * oacc[md][nq][j]; oacc[md][nq][j] = o; ss += o * o; }
          }
          ss += shx(ss, 16); ss += shx(ss, 32);
          const float r = rsqrtf(ss * (1.f / 128.f) + 1e-5f) * (1.f - 0.35550906759f);
#pragma unroll
          for (int md = 0; md < 8; ++md) {
            f4 gg = *(const f4*)(p.in[41] + md * 16 + fq * 4); h4 o;
#pragma unroll
            for (int j = 0; j < 4; ++j) o[j] = (hf)(oacc[md][nq][j] * r * gg[j]);
            *(h4*)(dst + md * 16) = o;
          }
        }
      }
    }
  }
  while (true) {
    __syncthreads();
    if (tid == 0) sItem = atomicAdd(counter + 1, 1);
    __syncthreads();
    const int item = sItem;
    if (item >= 1536) break;
    int seq, h, qt;
    if (item < 512) { seq = 4; h = item >> 6; qt = item & 63; }
    else { int it = item - 512; seq = it >> 8; h = (it >> 5) & 7; qt = it & 31; }
    const int s0 = seq_start(seq), L = seq_len(seq), q0 = qt * 256;
    f4 oacc[8][4];
    attn_pass<96, false>(qm + h * 96, 768, km + h * 96, 768, vtm + (size_t)h * 128 * T_TOK, s0, L, q0, 0.10206207262f * 1.44269504089f, nullptr, oacc, smem);
#pragma unroll
    for (int nq = 0; nq < 4; ++nq)
#pragma unroll
      for (int md = 0; md < 8; ++md)
        *(h4*)(mix + (size_t)(s0 + q0 + wv * 64 + nq * 16 + fr) * 2048 + h * 128 + md * 16 + fq * 4) = cvt4(oacc[md][nq]);
  }
}

__device__ __forceinline__ void ffn_layer(const Params& p, cg::grid_group& grid, int layer, char* smem) {
  const hf* W = (const hf*)(p.ws + OFF_W);
  const hf* wup = W + (layer == 0 ? W0_FUP : W1_FUP); const hf* wdn = W + (layer == 0 ? W0_FDN : W1_FDN);
  const hf* h16 = (const hf*)(p.ws + OFF_RA);
  hf* u16 = (hf*)(p.ws + OFF_RB); hf* act = (hf*)(p.ws + OFF_ACT);
  const float* mod = (const float*)(p.ws + OFF_SMALL + SM_MOD) + (size_t)layer * 5 * 12288;
  for (int slab = 0; slab < 3; ++slab) {
    gemm_run(GemmArgs{h16 + (size_t)slab * 16384 * 2048, 2048, 0, wup, 2048, 0, 16384, 11264, 2048, 1}, EpiStore{u16, 11264}, smem);
    grid.sync();
    convact_phase(p, layer, slab);
    grid.sync();
    gemm_run(GemmArgs{act, 5632, 0, wdn, 5632, 0, 16384, 2048, 5632, 1}, EpiResid{p.out, mod + 5 * 2048, slab * 16384}, smem);
    grid.sync();
  }
}

__global__ void __launch_bounds__(256, 1) mega(Params p) {
  cg::grid_group grid = cg::this_grid();
  extern __shared__ __attribute__((aligned(16))) char smem[];
  hf* W = (hf*)(p.ws + OFF_W);
  float* mod = (float*)(p.ws + OFF_SMALL + SM_MOD);

  if (blockIdx.x == 0 && tidx() == 0) { int* cnt = (int*)(p.ws + OFF_SMALL + SM_CNT); cnt[0] = 0; cnt[1] = 0; cnt[2] = 0; cnt[3] = 0; }
  adaln_phase(p, smem);
  s5_tabA(p, smem);
  cvt_t(p.in[8], W + W0_IN, 2048, 4480, smem);
  cvt_t(p.in[9], W + W0_OUT, 2048, 2048, smem);
  cvt_t(p.in[29], W + W0_GLU, 1024, 1024, smem);
  cvt_t(p.in[15], W + W0_GUP, 128, 1024, smem);
  cvt_t(p.in[43], W + W0_FUP, 2048, 11264, smem);
  cvt_t(p.in[46], W + W0_FDN, 5632, 2048, smem);
  grid.sync();
  norm_phase(p, 0, 0, true);
  s5_tabB(p);
  grid.sync();
  gemm_run(GemmArgs{(const hf*)(p.ws + OFF_RA), 2048, 0, W + W0_IN, 2048, 0, T_TOK, 4480, 2048, 1},
           EpiInproj0{(hf*)(p.ws + OFF_RB), (hf*)(p.ws + OFF_US5)}, smem);
  grid.sync();
  gemm_run(GemmArgs{(const hf*)(p.ws + OFF_US5), 768, (size_t)1536 * 768, (const hf*)(p.ws + OFF_S5M), 512, (size_t)256 * 512, 1536, 256, 512, 64},
           EpiS5p1{(float*)(p.ws + OFF_RA)}, smem);
  grid.sync();
  s5_carry(p);
  grid.sync();
  gemm_run(GemmArgs{(const hf*)(p.ws + OFF_US5), 768, (size_t)1536 * 768, (const hf*)(p.ws + OFF_S5M + 16 * MiB), 768, (size_t)512 * 768, 1536, 512, 768, 64},
           EpiS5p2{(hf*)(p.ws + OFF_RA + 96 * MiB)}, smem);
  grid.sync();
  gemm_run(GemmArgs{(const hf*)(p.ws + OFF_RA + 96 * MiB), 1024, 0, W + W0_GLU, 1024, 0, T_TOK, 1024, 1024, 1},
           EpiGlu{(const hf*)(p.ws + OFF_RA + 96 * MiB), p.in[30], (hf*)(p.ws + OFF_MIX0)}, smem);
  gate_prep(p);
  grid.sync();
  gemm_run(GemmArgs{(const hf*)(p.ws + OFF_US5 + 96 * MiB), 128, 0, W + W0_GUP, 128, 0, T_TOK, 1024, 128, 1},
           EpiStore{(hf*)(p.ws + OFF_US5), 1024}, smem);
  rwkv_scan_phase(p, smem);
#ifdef DUP_RWKV
  grid.sync();
  rwkv_scan_phase(p, smem);
#endif
  grid.sync();
  rwkv_post(p);
  grid.sync();
  gemm_run(GemmArgs{(const hf*)(p.ws + OFF_MIX0), 2048, 0, W + W0_OUT, 2048, 0, T_TOK, 2048, 2048, 1},
           EpiResid{p.out, mod + 2 * 2048, 0}, smem);
  grid.sync();
  norm_phase(p, 0, 1, false);
  grid.sync();
  ffn_layer(p, grid, 0, smem);
  cvt_t(p.in[31], W + W1_IN, 2048, 3872, smem);
  cvt_t(p.in[32], W + W1_OUT, 2048, 2048, smem);
  cvt_t(p.in[35], W + W1_UQ, 512, 768, smem);
  cvt_t(p.in[36], W + W1_UKV, 256, 1536, smem);
  cvt_t(p.in[43] + (size_t)2048 * 11264, W + W1_FUP, 2048, 11264, smem);
  cvt_t(p.in[46] + (size_t)5632 * 2048, W + W1_FDN, 5632, 2048, smem);
  norm_phase(p, 1, 0, false);
  grid.sync();
  gemm_run(GemmArgs{(const hf*)(p.ws + OFF_RA), 2048, 0, W + W1_IN, 2048, 0, T_TOK, 3872, 2048, 1},
           EpiInproj1{(hf*)(p.ws + OFF_RB), (hf*)(p.ws + OFF_VTD)}, smem);
  grid.sync();
  mla_prep(p);
  grid.sync();
  gemm_run(GemmArgs{(const hf*)(p.ws + OFF_MIX1), 512, 0, W + W1_UQ, 512, 0, T_TOK, 768, 512, 1},
           EpiStore{(hf*)(p.ws + OFF_RA), 768}, smem);
  gemm_run(GemmArgs{(const hf*)(p.ws + OFF_MIX1 + 48 * MiB), 256, 0, W + W1_UKV, 256, 0, T_TOK, 1536, 256, 1},
           EpiUkv{(hf*)(p.ws + OFF_RA + 72 * MiB), (hf*)(p.ws + OFF_VTM)}, smem);
  grid.sync();
  q_rope(p);
  grid.sync();
  attn_phase(p, smem, 0);
#ifdef DUP_ATTN
  grid.sync();
  attn_phase(p, smem, 2);
#endif
  grid.sync();
  gemm_run(GemmArgs{(const hf*)(p.ws + OFF_MIX1), 2048, 0, W + W1_OUT, 2048, 0, T_TOK, 2048, 2048, 1},
           EpiResid{p.out, mod + (size_t)5 * 12288 + 2 * 2048, 0}, smem);
  grid.sync();
  norm_phase(p, 1, 1, false);
  grid.sync();
  ffn_layer(p, grid, 1, smem);
  final_norm(p);
}

extern "C" void kernel_launch(void* const* d_in, const int* in_sizes, int n_in, void* d_out, int out_size,
                              void* d_ws, size_t ws_size, hipStream_t stream) {
  static int grid_blocks = 0;
  if (!grid_blocks) {
    int dev = 0, cus = 0, per_cu = 0;
    (void)hipGetDevice(&dev);
    (void)hipDeviceGetAttribute(&cus, hipDeviceAttributeMultiprocessorCount, dev);
    (void)hipFuncSetAttribute((const void*)mega, hipFuncAttributeMaxDynamicSharedMemorySize, DYN_LDS);
    (void)hipOccupancyMaxActiveBlocksPerMultiprocessor(&per_cu, mega, 256, DYN_LDS);
    if (per_cu > 2) per_cu = 2;
    if (per_cu < 1) per_cu = 1;
    grid_blocks = cus * per_cu;
  }
  Params p{};
  for (int i = 0; i < 48; ++i) p.in[i] = (const float*)d_in[i];
  p.out = (float*)d_out; p.ws = (char*)d_ws; p.stop = STOP_AT;
  void* args[] = {&p};
  hipError_t e = hipLaunchCooperativeKernel((void*)mega, dim3(grid_blocks), dim3(256), args, DYN_LDS, stream);
  if (e != hipSuccess) fprintf(stderr, "cooperative launch failed: %s (grid %d)\n", hipGetErrorString(e), grid_blocks);
}
```

```cpp
#include <hip/hip_runtime.h>
#include <hip/hip_cooperative_groups.h>
#include <cstdio>
#include <cstdint>
namespace cg = cooperative_groups;
typedef _Float16 hf;
using h8 = __attribute__((ext_vector_type(8))) _Float16;
using h4 = __attribute__((ext_vector_type(4))) _Float16;
using f4 = __attribute__((ext_vector_type(4))) float;
using u4 = __attribute__((ext_vector_type(4))) unsigned;

#define T_TOK 49152
#ifndef STOP_AT
#define STOP_AT 100
#endif
#define DI __device__ __forceinline__
constexpr size_t MiB = 1ull << 20;

struct Params {
  const float* in[48];
  float* out;
  char* ws;
  long stop;
};

constexpr size_t OFF_W = 0;
constexpr size_t OFF_RA = 96 * MiB;
constexpr size_t OFF_RB = 288 * MiB;
constexpr size_t OFF_US5 = 612 * MiB;
constexpr size_t OFF_MIX0 = 756 * MiB;
constexpr size_t OFF_S5M = 948 * MiB;
constexpr size_t OFF_SMALL = 1012 * MiB;
constexpr size_t OFF_ACT = 640 * MiB;
constexpr size_t OFF_VTD = 555 * MiB;
constexpr size_t OFF_VTM = 651 * MiB;
constexpr size_t OFF_MIX1 = 747 * MiB;
constexpr size_t SM_MOD = 0;
constexpr size_t SM_CNT = 512 * 1024;
constexpr size_t SM_KTAB = 1 * MiB;
constexpr size_t SM_BONUS = 5 * MiB;
constexpr size_t W0_IN = 0, W0_OUT = 9175040, W0_GLU = 13369344, W0_GUP = 14417920, W0_FUP = 14548992, W0_FDN = 37617664;
constexpr size_t W1_IN = 0, W1_OUT = 7929856, W1_UQ = 12124160, W1_UKV = 12517376, W1_FUP = 12910592, W1_FDN = 35979264;

DI int tidx() { int t = __builtin_amdgcn_workitem_id_x(); asm volatile("" : "+v"(t)); return t; }
DI float shx(float x, int m) {
  const int xi = __builtin_bit_cast(int, x); int r;
  switch (m) {
    case 1: r = __builtin_amdgcn_ds_swizzle(xi, 0x041f); break;
    case 2: r = __builtin_amdgcn_ds_swizzle(xi, 0x081f); break;
    case 4: r = __builtin_amdgcn_ds_swizzle(xi, 0x101f); break;
    case 8: r = __builtin_amdgcn_ds_swizzle(xi, 0x201f); break;
    case 16: r = __builtin_amdgcn_ds_swizzle(xi, 0x401f); break;
    default: r = __builtin_amdgcn_ds_bpermute(((tidx() & 63) ^ m) << 2, xi); break;
  }
  return __builtin_bit_cast(float, r);
}
DI int seq_of(int t) { return t < 32768 ? (t >> 13) : 4; }
DI int seq_start(int s) { return s < 4 ? s * 8192 : 32768; }
DI int seq_len(int s) { return s < 4 ? 8192 : 16384; }
DI float sigmoidf_(float x) { return 1.f / (1.f + __expf(-x)); }
DI h4 cvt4(f4 v) { h4 r; r[0] = (hf)v[0]; r[1] = (hf)v[1]; r[2] = (hf)v[2]; r[3] = (hf)v[3]; return r; }
DI void sincos_red(float x, float& s, float& c) {
  double a = (double)x; double n = rint(a * 0.15915494309189535); float r = (float)(a - n * 6.283185307179586);
  s = __sinf(r); c = __cosf(r);
}
DI float allred16(float x) {
  x += __builtin_bit_cast(float, __builtin_amdgcn_update_dpp(0, __builtin_bit_cast(int, x), 0x128, 0xf, 0xf, false));
  x += __builtin_bit_cast(float, __builtin_amdgcn_update_dpp(0, __builtin_bit_cast(int, x), 0x124, 0xf, 0xf, false));
  x += __builtin_bit_cast(float, __builtin_amdgcn_update_dpp(0, __builtin_bit_cast(int, x), 0x122, 0xf, 0xf, false));
  x += __builtin_bit_cast(float, __builtin_amdgcn_update_dpp(0, __builtin_bit_cast(int, x), 0x121, 0xf, 0xf, false));
  return x;
}
DI float max3_(float a, float b, float c) { float r; asm("v_max3_f32 %0, %1, %2, %3" : "=v"(r) : "v"(a), "v"(b), "v"(c)); return r; }
DI void mfma16_acc(f4& c, h8 a, h8 b) { asm("v_mfma_f32_16x16x32_f16 %0, %1, %2, %0" : "+a"(c) : "v"(a), "v"(b)); }
DI f4 mfma16(h8 a, h8 b, f4 c) { return __builtin_amdgcn_mfma_f32_16x16x32_f16(a, b, c, 0, 0, 0); }

__device__ __forceinline__ void cvt_t(const float* __restrict__ src, hf* __restrict__ dst, int K, int N, char* smem) {
  float* tile = (float*)smem;
  const int tk = K >> 6, tn = N >> 5, total = tk * tn, tid = tidx();
  for (int t = blockIdx.x; t < total; t += gridDim.x) {
    int kt = t / tn, nt = t - kt * tn;
    __syncthreads();
    int n = tid & 31, kr = tid >> 5;
#pragma unroll
    for (int i = 0; i < 8; ++i) tile[(kr + 8 * i) * 33 + n] = src[(size_t)(kt * 64 + kr + 8 * i) * N + nt * 32 + n];
    __syncthreads();
    int on = tid >> 3, ok = (tid & 7) * 8;
    h8 o;
#pragma unroll
    for (int e = 0; e < 8; ++e) o[e] = (hf)tile[(ok + e) * 33 + on];
    *(h8*)(dst + (size_t)(nt * 32 + on) * K + kt * 64 + ok) = o;
  }
}

__device__ __forceinline__ void adaln_phase(const Params& p, char* smem) {
  float* scs = (float*)smem;
  float* red = scs + 5 * 2048;
  float* mod = (float*)(p.ws + OFF_SMALL + SM_MOD);
  const int tid = tidx();
  __syncthreads();
  for (int i = tid; i < 5 * 2048; i += 256) {
    int s = i >> 11, k = i & 2047;
    float c = s < 4 ? p.in[2][s * 2048 + k] : p.in[3][k];
    scs[i] = c / (1.f + __expf(-c));
  }
  __syncthreads();
  for (int item = blockIdx.x; item < 384; item += gridDim.x) {
    int layer = item / 192, cb = item % 192, cl = tid & 63, kp = tid >> 6, col = cb * 64 + cl;
    const float* w = p.in[4] + (size_t)layer * 2048 * 12288 + col;
    float a0 = 0, a1 = 0, a2 = 0, a3 = 0, a4 = 0;
#pragma unroll 8
    for (int k = kp * 512; k < kp * 512 + 512; ++k) {
      float wv = w[(size_t)k * 12288];
      a0 += scs[k] * wv; a1 += scs[2048 + k] * wv; a2 += scs[4096 + k] * wv; a3 += scs[6144 + k] * wv; a4 += scs[8192 + k] * wv;
    }
    red[(kp * 5 + 0) * 64 + cl] = a0; red[(kp * 5 + 1) * 64 + cl] = a1; red[(kp * 5 + 2) * 64 + cl] = a2;
    red[(kp * 5 + 3) * 64 + cl] = a3; red[(kp * 5 + 4) * 64 + cl] = a4;
    __syncthreads();
    if (kp == 0) {
      float bb = p.in[5][layer * 12288 + col];
#pragma unroll
      for (int s = 0; s < 5; ++s)
        mod[(size_t)(layer * 5 + s) * 12288 + col] = red[s * 64 + cl] + red[(5 + s) * 64 + cl] + red[(10 + s) * 64 + cl] + red[(15 + s) * 64 + cl] + bb;
    }
    __syncthreads();
  }
}

__device__ __forceinline__ void s5_tabA(const Params& p, char* smem) {
  float* apow = (float*)smem;
  float* BB = apow + 33 * 128;
  float* CC = BB + 2048;
  float* sF = CC + 2048;
  float* Ktab = (float*)(p.ws + OFF_SMALL + SM_KTAB);
  hf* Bt1 = (hf*)(p.ws + OFF_S5M);
  hf* Bt2 = (hf*)(p.ws + OFF_S5M + 16 * MiB);
  const int tid = tidx();
  for (int item = blockIdx.x; item < 128; item += gridDim.x) {
    int g = item >> 1, d = item & 1;
    __syncthreads();
    if (tid < 64) {
      int pp = tid;
      float step = __expf(p.in[23][d * 64 + g]);
      float lr = p.in[21][(d * 64 + g) * 64 + pp], li = p.in[22][(d * 64 + g) * 64 + pp];
      float mag = __expf(lr * step), sn, cs; sincos_red(li * step, sn, cs);
      float ar = mag * cs, ai = mag * sn, den = lr * lr + li * li, nr = ar - 1.f, ni = ai;
      sF[pp * 2] = (nr * lr + ni * li) / den; sF[pp * 2 + 1] = (ni * lr - nr * li) / den;
      float pr = 1.f, pi = 0.f;
      for (int tau = 0; tau <= 32; ++tau) {
        apow[(tau * 64 + pp) * 2] = pr; apow[(tau * 64 + pp) * 2 + 1] = pi;
        float nr2 = pr * ar - pi * ai, ni2 = pr * ai + pi * ar; pr = nr2; pi = ni2;
      }
    }
    __syncthreads();
    for (int idx = tid; idx < 1024; idx += 256) {
      int pp = idx >> 4, c = idx & 15;
      float br = p.in[24][((size_t)(d * 64 + g) * 64 + pp) * 16 + c], bi = p.in[25][((size_t)(d * 64 + g) * 64 + pp) * 16 + c];
      float fr = sF[pp * 2], fi = sF[pp * 2 + 1];
      BB[idx * 2] = fr * br - fi * bi; BB[idx * 2 + 1] = fr * bi + fi * br;
      int c2 = idx >> 6, p2 = idx & 63;
      CC[idx * 2] = p.in[26][((size_t)(d * 64 + g) * 16 + c2) * 64 + p2]; CC[idx * 2 + 1] = p.in[27][((size_t)(d * 64 + g) * 16 + c2) * 64 + p2];
    }
    __syncthreads();
    {
      int c = tid >> 4, c1 = tid & 15;
      for (int tau = 0; tau < 32; ++tau) {
        float acc = 0.f;
        for (int pp = 0; pp < 64; ++pp) {
          float cr = CC[(c * 64 + pp) * 2], ci = CC[(c * 64 + pp) * 2 + 1];
          float pr = apow[(tau * 64 + pp) * 2], pi = apow[(tau * 64 + pp) * 2 + 1];
          float wr = cr * pr - ci * pi, wi = cr * pi + ci * pr;
          acc += wr * BB[(pp * 16 + c1) * 2] - wi * BB[(pp * 16 + c1) * 2 + 1];
        }
        Ktab[((size_t)(g * 2 + d) * 32 + tau) * 256 + c * 16 + c1] = acc;
      }
    }
    for (int idx = tid; idx < 128 * 512; idx += 256) {
      int nl = idx >> 9, k = idx & 511, ri = nl >> 6, pp = nl & 63, s = k >> 4, c1 = k & 15;
      int e = d == 0 ? 31 - s : s;
      float pr = apow[(e * 64 + pp) * 2], pi = apow[(e * 64 + pp) * 2 + 1];
      float br = BB[(pp * 16 + c1) * 2], bi = BB[(pp * 16 + c1) * 2 + 1];
      float v = ri ? (pr * bi + pi * br) : (pr * br - pi * bi);
      Bt1[((size_t)g * 256 + d * 128 + nl) * 512 + k] = (hf)(v * 256.f);
    }
    for (int idx = tid; idx < 512 * 128; idx += 256) {
      int n = idx >> 7, kk = idx & 127, ri = kk >> 6, pp = kk & 63, t = n >> 4, c = n & 15;
      int pw = d == 0 ? t + 1 : 32 - t;
      float cr = CC[(c * 64 + pp) * 2], ci = CC[(c * 64 + pp) * 2 + 1];
      float pr = apow[(pw * 64 + pp) * 2], pi = apow[(pw * 64 + pp) * 2 + 1];
      float v = ri ? -(cr * pi + ci * pr) : (cr * pr - ci * pi);
      Bt2[((size_t)g * 512 + n) * 768 + 512 + d * 128 + kk] = (hf)v;
    }
  }
}

__device__ __forceinline__ void s5_tabB(const Params& p) {
  const float* Ktab = (const float*)(p.ws + OFF_SMALL + SM_KTAB);
  hf* Bt2 = (hf*)(p.ws + OFF_S5M + 16 * MiB);
  const float* dsk = p.in[28];
  for (int idx = blockIdx.x * 256 + tidx(); idx < 64 * 512 * 64; idx += gridDim.x * 256) {
    int kc = idx & 63, n = (idx >> 6) & 511, g = idx >> 15;
    int t = n >> 4, c = n & 15, s = kc >> 1, c0 = (kc & 1) * 8;
    h8 o;
    if (t != s) {
      int d = t > s ? 0 : 1, tau = t > s ? t - s : s - t;
      const float* kp = Ktab + ((size_t)(g * 2 + d) * 32 + tau) * 256 + c * 16 + c0;
#pragma unroll
      for (int e = 0; e < 8; ++e) o[e] = (hf)(kp[e] * 256.f);
    } else {
      const float* k0 = Ktab + ((size_t)(g * 2 + 0) * 32) * 256 + c * 16 + c0;
      const float* k1 = Ktab + ((size_t)(g * 2 + 1) * 32) * 256 + c * 16 + c0;
      float ds = dsk[g * 16 + c];
#pragma unroll
      for (int e = 0; e < 8; ++e) o[e] = (hf)((k0[e] + k1[e] + ((c0 + e) == c ? ds : 0.f)) * 256.f);
    }
    *(h8*)(Bt2 + ((size_t)g * 512 + n) * 768 + kc * 8) = o;
  }
}

__device__ __forceinline__ void s5_carry(const Params& p) {
  const float* E = (const float*)(p.ws + OFF_RA);
  hf* us5 = (hf*)(p.ws + OFF_US5);
  for (int idx = blockIdx.x * 256 + tidx(); idx < 64 * 5 * 2 * 64; idx += gridDim.x * 256) {
    int pp = idx & 63, dd = (idx >> 6) & 1, sq = (idx >> 7) % 5, g = idx / 640;
    float step = __expf(p.in[23][dd * 64 + g]);
    float lr = p.in[21][(dd * 64 + g) * 64 + pp], li = p.in[22][(dd * 64 + g) * 64 + pp];
    float mag = __expf(lr * step), sn, cs; sincos_red(li * step, sn, cs);
    float ar = mag * cs, ai = mag * sn;
#pragma unroll
    for (int i = 0; i < 5; ++i) { float r2 = ar * ar - ai * ai, i2 = 2.f * ar * ai; ar = r2; ai = i2; }
    int c0 = seq_start(sq) >> 5, nc = seq_len(sq) >> 5;
    float cr = 0.f, ci = 0.f;
    int n = dd * 128 + pp;
    for (int j0 = 0; j0 < nc; j0 += 8) {
      float er[8], ei[8];
#pragma unroll
      for (int u = 0; u < 8; ++u) {
        int j = dd == 0 ? (j0 + u) : (nc - 1 - j0 - u);
        size_t o = ((size_t)g * 1536 + c0 + j) * 256 + n;
        er[u] = E[o]; ei[u] = E[o + 64];
      }
#pragma unroll
      for (int u = 0; u < 8; ++u) {
        int j = dd == 0 ? (j0 + u) : (nc - 1 - j0 - u);
        size_t o = ((size_t)g * 1536 + c0 + j) * 768 + 512 + n;
        us5[o] = (hf)cr; us5[o + 64] = (hf)ci;
        float nr = ar * cr - ai * ci + er[u], ni = ar * ci + ai * cr + ei[u]; cr = nr; ci = ni;
      }
    }
  }
}

__device__ __forceinline__ void norm_phase(const Params& p, int layer, int which, bool from_inputs) {
  const float* mod = (const float*)(p.ws + OFF_SMALL + SM_MOD) + (size_t)layer * 5 * 12288;
  const float* gain = (which == 0 ? p.in[6] : p.in[7]) + layer * 2048;
  hf* h16 = (hf*)(p.ws + OFF_RA);
  const int lane = tidx() & 63, gw = blockIdx.x * 4 + (tidx() >> 6), nw = gridDim.x * 4;
  const int o_sh = which == 0 ? 0 : 3 * 2048, o_sc = o_sh + 2048;
  for (int t = gw; t < T_TOK; t += nw) {
    const float* xr = from_inputs ? (t < 32768 ? p.in[0] + (size_t)t * 2048 : p.in[1] + (size_t)(t - 32768) * 2048) : p.out + (size_t)t * 2048;
    float4 v[8]; float ss = 0.f;
#pragma unroll
    for (int i = 0; i < 8; ++i) { v[i] = ((const float4*)xr)[i * 64 + lane]; ss += v[i].x * v[i].x + v[i].y * v[i].y + v[i].z * v[i].z + v[i].w * v[i].w; }
#pragma unroll
    for (int o = 32; o; o >>= 1) ss += shx(ss, o);
    float r = rsqrtf(ss * (1.f / 2048.f) + 1e-6f);
    const float* m = mod + (size_t)seq_of(t) * 12288;
#pragma unroll
    for (int i = 0; i < 8; ++i) {
      int idx = (i * 64 + lane) * 4;
      float4 g4 = *(const float4*)(gain + idx), sc = *(const float4*)(m + o_sc + idx), sh = *(const float4*)(m + o_sh + idx);
      h4 o;
      o[0] = (hf)(v[i].x * r * g4.x * (1.f + sc.x) + sh.x); o[1] = (hf)(v[i].y * r * g4.y * (1.f + sc.y) + sh.y);
      o[2] = (hf)(v[i].z * r * g4.z * (1.f + sc.z) + sh.z); o[3] = (hf)(v[i].w * r * g4.w * (1.f + sc.w) + sh.w);
      *(h4*)(h16 + (size_t)t * 2048 + idx) = o;
      if (from_inputs) *(float4*)(p.out + (size_t)t * 2048 + idx) = v[i];
    }
  }
}

__device__ __forceinline__ void final_norm(const Params& p) {
  const int lane = tidx() & 63, gw = blockIdx.x * 4 + (tidx() >> 6), nw = gridDim.x * 4;
  for (int t = gw; t < T_TOK; t += nw) {
    float* xr = p.out + (size_t)t * 2048;
    float4 v[8]; float ss = 0.f;
#pragma unroll
    for (int i = 0; i < 8; ++i) { v[i] = ((const float4*)xr)[i * 64 + lane]; ss += v[i].x * v[i].x + v[i].y * v[i].y + v[i].z * v[i].z + v[i].w * v[i].w; }
#pragma unroll
    for (int o = 32; o; o >>= 1) ss += shx(ss, o);
    float r = rsqrtf(ss * (1.f / 2048.f) + 1e-6f);
#pragma unroll
    for (int i = 0; i < 8; ++i) {
      int idx = (i * 64 + lane) * 4;
      float4 g4 = *(const float4*)(p.in[47] + idx);
      float4 o; o.x = v[i].x * r * g4.x; o.y = v[i].y * r * g4.y; o.z = v[i].z * r * g4.z; o.w = v[i].w * r * g4.w;
      *(float4*)(xr + idx) = o;
    }
  }
}

struct GemmArgs { const hf* A; size_t lda, sA; const hf* Bt; size_t ldb, sB; int M, N, K, nb; };

#define EPI_BEGIN _Pragma("unroll") for (int mi = 0; mi < 8; ++mi) _Pragma("unroll") for (int ni = 0; ni < 8; ++ni) { \
    const int row = row0 + mi * 16 + fr; const int c = col0 + ni * 16 + fq * 4; const f4 v = acc[mi][ni]; (void)row; (void)c; (void)b;
#define EPI_END __builtin_amdgcn_sched_barrier(0); }

constexpr int G_LD = 72;
constexpr int G_STAGE = 512 * G_LD;
constexpr int DYN_LDS = 2 * G_STAGE * 2;

template <class Epi>
__device__ __forceinline__ void gemm_run(const GemmArgs g, Epi epi, char* smem) {
  hf* sbase = (hf*)smem;
  const int tid = tidx(), lane = tid & 63, wv = tid >> 6, wm = wv >> 1, wn = wv & 1, fr = lane & 15, fq = lane >> 4;
  const int tm = g.M >> 8, tn = (g.N + 255) >> 8, per = tm * tn, total = per * g.nb, nk = g.K >> 6;
  const int lr = tid >> 3, lc = (tid & 7) * 8;
  const int lcw = ((tid & 7) ^ (((lr >> 2) ^ (lr >> 3)) & 1)) * 8;
  const int fqs = (fq ^ (((fr >> 2) ^ (fr >> 3)) & 1)) * 8;
  for (int tile = blockIdx.x; tile < total; tile += gridDim.x) {
    int gidx = tile;
    if (gridDim.x == 256 && (tile | 255) < total) { const int s = tile & 255; gidx = (tile & ~255) + (s & 7) * 32 + (s >> 3); }
    const int b = gidx / per, r = gidx - b * per;
    const int band = r / (tm * 8), rbn = r - band * tm * 8, bw = min(8, tn - band * 8);
    const int mt = rbn / bw, nt = band * 8 + rbn - mt * bw;
    const __amdgpu_buffer_rsrc_t Ars = __builtin_amdgcn_make_buffer_rsrc((void*)(g.A + (size_t)b * g.sA + (size_t)(mt * 256) * g.lda), 0, 0x7fffffff, 0x00020000);
    const __amdgpu_buffer_rsrc_t Brs = __builtin_amdgcn_make_buffer_rsrc((void*)(g.Bt + (size_t)b * g.sB + (size_t)(nt * 256) * g.ldb), 0, 0x7fffffff, 0x00020000);
    const int aoff = (lr * (int)g.lda + lc) * 2, boff = (lr * (int)g.ldb + lc) * 2;
    const int astep = 64 * (int)g.lda, bstep = 64 * (int)g.ldb;
    u4 ra[8], rb[8];
    f4 acc[8][8];
#pragma unroll
    for (int i = 0; i < 8; ++i)
#pragma unroll
      for (int j = 0; j < 8; ++j) acc[i][j] = (f4){0.f, 0.f, 0.f, 0.f};
    __syncthreads();
#pragma unroll
    for (int i = 0; i < 8; ++i) { ra[i] = __builtin_amdgcn_raw_buffer_load_b128(Ars, aoff, i * astep, 0); rb[i] = __builtin_amdgcn_raw_buffer_load_b128(Brs, boff, i * bstep, 0); }
#pragma unroll
    for (int i = 0; i < 8; ++i) { *(u4*)(sbase + (lr + 32 * i) * G_LD + lcw) = ra[i]; *(u4*)(sbase + (256 + lr + 32 * i) * G_LD + lcw) = rb[i]; }
    if (nk > 1) {
#pragma unroll
      for (int i = 0; i < 8; ++i) { ra[i] = __builtin_amdgcn_raw_buffer_load_b128(Ars, aoff, i * astep + 128, 0); rb[i] = __builtin_amdgcn_raw_buffer_load_b128(Brs, boff, i * bstep + 128, 0); }
    }
    __syncthreads();
    for (int kt = 0; kt < nk; ++kt) {
      const hf* sA = sbase + (kt & 1) * G_STAGE + (wm * 128 + fr) * G_LD + fqs;
      const hf* sB = sbase + (kt & 1) * G_STAGE + (256 + wn * 128 + fr) * G_LD + fqs;
      hf* st = sbase + ((kt + 1) & 1) * G_STAGE;
#pragma unroll
      for (int ks = 0; ks < 2; ++ks) {
        h8 af[8];
#pragma unroll
        for (int i = 0; i < 8; ++i) af[i] = *(const h8*)(sA + i * 16 * G_LD + ks * 32);
#pragma unroll
        for (int nh = 0; nh < 2; ++nh) {
          h8 bf[4];
#pragma unroll
          for (int i = 0; i < 4; ++i) bf[i] = *(const h8*)(sB + (nh * 4 + i) * 16 * G_LD + ks * 32);
          if (ks == 0 && kt + 1 < nk) {
            if (nh == 0) {
#pragma unroll
              for (int i = 0; i < 8; ++i) *(u4*)(st + (lr + 32 * i) * G_LD + lcw) = ra[i];
            } else {
#pragma unroll
              for (int i = 0; i < 8; ++i) *(u4*)(st + (256 + lr + 32 * i) * G_LD + lcw) = rb[i];
            }
          }
          if (ks == 1 && nh == 0 && kt + 2 < nk) {
            const int ko = (kt + 2) * 64;
#pragma unroll
            for (int i = 0; i < 8; ++i) { ra[i] = __builtin_amdgcn_raw_buffer_load_b128(Ars, aoff, i * astep + ko * 2, 0); rb[i] = __builtin_amdgcn_raw_buffer_load_b128(Brs, boff, i * bstep + ko * 2, 0); }
          }
          __builtin_amdgcn_sched_barrier(0);
#pragma unroll
          for (int mi = 0; mi < 8; ++mi)
#pragma unroll
            for (int ni = 0; ni < 4; ++ni) mfma16_acc(acc[mi][nh * 4 + ni], bf[ni], af[mi]);
          __builtin_amdgcn_sched_barrier(0);
        }
      }
      __syncthreads();
    }
    epi(acc, b, mt * 256 + wm * 128, nt * 256 + wn * 128, fr, fq);
  }
}

struct EpiInproj0 { hf* prw; hf* us5;
  DI void operator()(f4 (&acc)[8][8], int b, int row0, int col0, int fr, int fq) const {
    EPI_BEGIN
      if (c < 3456) *(h4*)(prw + (size_t)row * 3456 + c) = cvt4(v);
      else if (c < 4480) { int cu = c - 3456, g = cu >> 4, cc = cu & 15; *(h4*)(us5 + ((size_t)g * 1536 + (row >> 5)) * 768 + (row & 31) * 16 + cc) = cvt4(v); }
    EPI_END } };
struct EpiS5p1 { float* E;
  DI void operator()(f4 (&acc)[8][8], int b, int row0, int col0, int fr, int fq) const {
    EPI_BEGIN
      *(f4*)(E + ((size_t)b * 1536 + row) * 256 + c) = v;
    EPI_END } };
struct EpiS5p2 { hf* z16;
  DI void operator()(f4 (&acc)[8][8], int b, int row0, int col0, int fr, int fq) const {
    EPI_BEGIN
      int tok = row * 32 + (c >> 4), cc = c & 15; h4 o;
#pragma unroll
      for (int j = 0; j < 4; ++j) { float y = v[j] * (1.f / 256.f); float u = 0.7978845608f * (y + 0.044715f * y * y * y); float th = 1.f - 2.f / (1.f + __expf(2.f * u)); o[j] = (hf)(0.5f * y * (1.f + th)); }
      *(h4*)(z16 + (size_t)tok * 1024 + b * 16 + cc) = o;
    EPI_END } };
struct EpiGlu { const hf* z16; const float* bglu; hf* mix;
  DI void operator()(f4 (&acc)[8][8], int b, int row0, int col0, int fr, int fq) const {
    EPI_BEGIN
      h4 z = *(const h4*)(z16 + (size_t)row * 1024 + c); f4 bb = *(const f4*)(bglu + c); h4 o;
#pragma unroll
      for (int j = 0; j < 4; ++j) o[j] = (hf)((float)z[j] * sigmoidf_(v[j] + bb[j]));
      *(h4*)(mix + (size_t)row * 2048 + 1024 + c) = o;
    EPI_END } };
struct EpiStore { hf* dst; size_t ld;
  DI void operator()(f4 (&acc)[8][8], int b, int row0, int col0, int fr, int fq) const {
    EPI_BEGIN
      *(h4*)(dst + (size_t)row * ld + c) = cvt4(v);
    EPI_END } };
struct EpiResid { float* x; const float* gate; int tok0;
  DI void operator()(f4 (&acc)[8][8], int b, int row0, int col0, int fr, int fq) const {
    EPI_BEGIN
      int tok = tok0 + row; const float* gp = gate + (size_t)seq_of(tok) * 12288 + c; f4 gg = *(const f4*)gp;
      f4* xp = (f4*)(x + (size_t)tok * 2048 + c); f4 xv = *xp;
      xv[0] += gg[0] * v[0]; xv[1] += gg[1] * v[1]; xv[2] += gg[2] * v[2]; xv[3] += gg[3] * v[3]; *xp = xv;
    EPI_END } };
struct EpiInproj1 { hf* p1; hf* vtd;
  DI void operator()(f4 (&acc)[8][8], int b, int row0, int col0, int fr, int fq) const {
    EPI_BEGIN
      if (c < 2848) *(h4*)(p1 + (size_t)row * 2848 + c) = cvt4(v);
      else if (c < 3872) { int cd = c - 2848;
#pragma unroll
        for (int j = 0; j < 4; ++j) vtd[(size_t)(cd + j) * T_TOK + row] = (hf)v[j]; }
    EPI_END } };
struct EpiUkv { hf* km; hf* vtm;
  DI void operator()(f4 (&acc)[8][8], int b, int row0, int col0, int fr, int fq) const {
    EPI_BEGIN
      int head = c / 192, d = c - head * 192;
      if (d < 64) *(h4*)(km + ((size_t)row * 8 + head) * 96 + d) = cvt4(v);
      else {
#pragma unroll
        for (int j = 0; j < 4; ++j) vtm[(size_t)(head * 128 + d - 64 + j) * T_TOK + row] = (hf)v[j]; }
    EPI_END } };

typedef float f2 __attribute__((ext_vector_type(2)));
constexpr int RV_TS = 324;
template <int RPL>
__device__ __forceinline__ void rwkv_item(const Params& p, int seq, int head, int dir, int slab, char* smem) {
  float* sVec = (float*)smem;
  float* sV = sVec + 32 * RV_TS;
  hf* sTw = (hf*)(sV + 32 * 64);
  hf* sDa = sTw + 32 * 72;
  float* sBon = (float*)(sDa + 32 * 72);
  const int tid = tidx(), lane = tid & 63, wv = tid >> 6, fr = lane & 15, fq = lane >> 4;
  const int L = seq_len(seq), s0 = seq_start(seq);
  const hf* P = (const hf*)(p.ws + OFF_RB);
  hf* yout = (hf*)(p.ws + OFF_RA) + (size_t)dir * T_TOK * 1024;
  float* bonus = (float*)(p.ws + OFF_SMALL + SM_BONUS);
  const float* mu = p.in[10];
  const int chg = head * 64 + wv * 16 + fr;
  h8 wf[2], af2[2];
#pragma unroll
  for (int ks = 0; ks < 2; ++ks)
#pragma unroll
    for (int e = 0; e < 8; ++e) {
      int r = ks * 32 + fq * 8 + e;
      wf[ks][e] = (hf)p.in[12][(size_t)(dir * 64 + r) * 1024 + chg];
      af2[ks][e] = (hf)p.in[14][(size_t)(dir * 64 + r) * 1024 + chg];
    }
  const float c_w0 = p.in[11][dir * 1024 + chg], c_a0 = p.in[13][dir * 1024 + chg], c_ka = p.in[17][chg], c_rk = p.in[18][chg];
  const int li_t = tid >> 3, part = tid & 7;
  int gcol[5] = {head * 64 + part * 8, 1024 + head * 64 + part * 8, 2048 + head * 64 + part * 8, 3072 + dir * 64 + part * 8, 3200 + dir * 64 + part * 8};
  u4 raw[5][3];
  const int nch = L >> 5;
  auto load_raw = [&](int c) {
    int t0 = dir ? L - 32 * (c + 1) : 32 * c; int tl = t0 + li_t;
#pragma unroll
    for (int g = 0; g < 5; ++g)
#pragma unroll
      for (int n = 0; n < 3; ++n) {
        int tt = tl + n - 1;
        raw[g][n] = (tt >= 0 && tt < L) ? *(const u4*)(P + (size_t)(s0 + tt) * 3456 + gcol[g]) : (u4){0u, 0u, 0u, 0u};
      }
  };
  f2 S01[RPL], S23[RPL];
#pragma unroll
  for (int r = 0; r < RPL; ++r) { S01[r] = (f2){0.f, 0.f}; S23[r] = (f2){0.f, 0.f}; }
  const int ks_ = tid & 15, rg = tid >> 4, rbase = slab * (16 * RPL) + rg * RPL;
  load_raw(0);
  for (int c = 0; c < nch; ++c) {
    const int t0 = dir ? L - 32 * (c + 1) : 32 * c;
    __syncthreads();
#pragma unroll
    for (int g = 0; g < 5; ++g) {
      h8 pv = __builtin_bit_cast(h8, raw[g][0]), cv = __builtin_bit_cast(h8, raw[g][1]), nv = __builtin_bit_cast(h8, raw[g][2]);
      float mx[8];
      const f4 m0 = *(const f4*)(mu + gcol[g]), m1 = *(const f4*)(mu + gcol[g] + 4);
#pragma unroll
      for (int e = 0; e < 8; ++e) { float cu = (float)cv[e]; float mm = e < 4 ? m0[e & 3] : m1[e & 3]; mx[e] = cu + mm * (0.5f * ((float)pv[e] + (float)nv[e]) - cu); }
      float* vb = sVec + li_t * RV_TS + part * 8;
      if (g == 0) {
        *(f4*)(vb + 256) = (f4){mx[0], mx[1], mx[2], mx[3]}; *(f4*)(vb + 260) = (f4){mx[4], mx[5], mx[6], mx[7]};
      } else if (g == 1) {
        const f4 k0 = *(const f4*)(p.in[16] + head * 64 + part * 8), k1 = *(const f4*)(p.in[16] + head * 64 + part * 8 + 4);
        float kkv[8], ss = 0.f;
#pragma unroll
        for (int e = 0; e < 8; ++e) { kkv[e] = mx[e] * (e < 4 ? k0[e & 3] : k1[e & 3]); ss += kkv[e] * kkv[e]; }
        *(f4*)(vb + 192) = (f4){mx[0], mx[1], mx[2], mx[3]}; *(f4*)(vb + 196) = (f4){mx[4], mx[5], mx[6], mx[7]};
        ss += shx(ss, 1); ss += shx(ss, 2); ss += shx(ss, 4);
        float inv = 1.f / fmaxf(sqrtf(ss), 1e-12f);
        *(f4*)(vb + 64) = (f4){kkv[0] * inv, kkv[1] * inv, kkv[2] * inv, kkv[3] * inv};
        *(f4*)(vb + 68) = (f4){kkv[4] * inv, kkv[5] * inv, kkv[6] * inv, kkv[7] * inv};
      } else if (g == 2) {
        *(f4*)(sV + li_t * 64 + part * 8) = (f4){mx[0], mx[1], mx[2], mx[3]}; *(f4*)(sV + li_t * 64 + part * 8 + 4) = (f4){mx[4], mx[5], mx[6], mx[7]};
      } else if (g == 3) {
        h8 o;
#pragma unroll
        for (int e = 0; e < 8; ++e) o[e] = (hf)(1.f - 2.f / (1.f + __expf(2.f * mx[e])));
        *(h8*)(sTw + li_t * 72 + part * 8) = o;
      } else {
        h8 o;
#pragma unroll
        for (int e = 0; e < 8; ++e) o[e] = (hf)mx[e];
        *(h8*)(sDa + li_t * 72 + part * 8) = o;
      }
    }
    if (tid < 32) sBon[tid] = 0.f;
    __syncthreads();
    if (c + 1 < nch) load_raw(c + 1);
#pragma unroll
    for (int mt = 0; mt < 2; ++mt) {
      f4 accw = {0.f, 0.f, 0.f, 0.f}, acca = {0.f, 0.f, 0.f, 0.f};
#pragma unroll
      for (int ks = 0; ks < 2; ++ks) {
        h8 a1 = *(const h8*)(sTw + (mt * 16 + fr) * 72 + ks * 32 + fq * 8);
        h8 a2 = *(const h8*)(sDa + (mt * 16 + fr) * 72 + ks * 32 + fq * 8);
        accw = mfma16(a1, wf[ks], accw); acca = mfma16(a2, af2[ks], acca);
      }
      const int ch = wv * 16 + fr;
#pragma unroll
      for (int j = 0; j < 4; ++j) {
        int l2 = mt * 16 + fq * 4 + j;
        float* vb = sVec + l2 * RV_TS + ch;
        float dec = __expf(-0.6065306597f * sigmoidf_(c_w0 + accw[j]));
        float icl = sigmoidf_(c_a0 + acca[j]);
        float kx = vb[192], kkv = vb[64];
        float kd = kx * (1.f + (icl - 1.f) * c_ka);
        vb[0] = dec; vb[128] = icl * kkv; vb[192] = kd;
        if (slab == 0) {
          float bon = allred16(vb[256] * kd * c_rk);
          if (fr == 0) atomicAdd(&sBon[l2], bon);
        }
      }
    }
    __syncthreads();
    if (slab == 0 && tid < 32) bonus[((size_t)(s0 + t0 + tid) * 16 + head) * 2 + dir] = sBon[tid];
#pragma unroll 4
    for (int i = 0; i < 32; ++i) {
      const int li = dir ? 31 - i : i;
      const float* base = sVec + li * RV_TS + ks_ * 4;
      const f4 w4 = *(const f4*)(base), kk4 = *(const f4*)(base + 64), b4 = *(const f4*)(base + 128),
               kd4 = *(const f4*)(base + 192), r4 = *(const f4*)(base + 256);
      const f2 w01 = {w4[0], w4[1]}, w23 = {w4[2], w4[3]}, kk01 = {kk4[0], kk4[1]}, kk23 = {kk4[2], kk4[3]};
      const f2 b01 = {b4[0], b4[1]}, b23 = {b4[2], b4[3]}, kd01 = {kd4[0], kd4[1]}, kd23 = {kd4[2], kd4[3]};
      const f2 r01 = {r4[0], r4[1]}, r23 = {r4[2], r4[3]};
      float vv[RPL], yv[RPL];
      if (RPL == 4) { const f4 v4 = *(const f4*)(sV + li * 64 + rbase); vv[0] = v4[0]; vv[1 % RPL] = v4[1]; vv[2 % RPL] = v4[2]; vv[3 % RPL] = v4[3]; }
      else {
#pragma unroll
        for (int r = 0; r < RPL; ++r) vv[r] = sV[li * 64 + rbase + r];
      }
#pragma unroll
      for (int r = 0; r < RPL; ++r) {
        f2 t = S01[r] * kk01; t = S23[r] * kk23 + t;
        const float sa = allred16(t[0] + t[1]);
        const f2 nsa = {-sa, -sa}, v2 = {vv[r], vv[r]};
        S01[r] = v2 * kd01 + (nsa * b01 + S01[r] * w01);
        S23[r] = v2 * kd23 + (nsa * b23 + S23[r] * w23);
        f2 u = S01[r] * r01; u = S23[r] * r23 + u;
        yv[r] = allred16(u[0] + u[1]);
      }
      if (ks_ == 0) {
        hf* yp = yout + (size_t)(s0 + t0 + li) * 1024 + head * 64 + rbase;
        if (RPL == 4) { h4 o; o[0] = (hf)yv[0]; o[1] = (hf)yv[1 % RPL]; o[2] = (hf)yv[2 % RPL]; o[3] = (hf)yv[3 % RPL]; *(h4*)yp = o; }
        else {
#pragma unroll
          for (int r = 0; r < RPL; ++r) yp[r] = (hf)yv[r];
        }
      }
    }
  }
}

__device__ __forceinline__ void rwkv_scan_phase(const Params& p, char* smem) {
  for (int item = blockIdx.x; item < 256; item += gridDim.x) {
    if (item < 128) rwkv_item<1>(p, 4, item >> 3, (item >> 2) & 1, item & 3, smem);
    else { int it = item - 128; rwkv_item<4>(p, it >> 5, (it >> 1) & 15, it & 1, 0, smem); }
  }
}

__device__ __forceinline__ void gate_prep(const Params& p) {
  const hf* P = (const hf*)(p.ws + OFF_RB);
  hf* sg = (hf*)(p.ws + OFF_US5 + 96 * MiB);
  const float* mu = p.in[10];
  for (int idx = blockIdx.x * 256 + tidx(); idx < T_TOK * 16; idx += gridDim.x * 256) {
    int t = idx >> 4, part = idx & 15, col = 3328 + part * 8;
    int sq = seq_of(t), pos = t - seq_start(sq), L = seq_len(sq);
    h8 cv = *(const h8*)(P + (size_t)t * 3456 + col), pv, nv;
    for (int e = 0; e < 8; ++e) { pv[e] = (hf)0; nv[e] = (hf)0; }
    if (pos > 0) pv = *(const h8*)(P + (size_t)(t - 1) * 3456 + col);
    if (pos < L - 1) nv = *(const h8*)(P + (size_t)(t + 1) * 3456 + col);
    h8 o;
#pragma unroll
    for (int e = 0; e < 8; ++e) { float cu = (float)cv[e]; float mx = cu + mu[col + e] * (0.5f * ((float)pv[e] + (float)nv[e]) - cu); o[e] = (hf)sigmoidf_(mx); }
    *(h8*)(sg + (size_t)t * 128 + part * 8) = o;
  }
}

__device__ __forceinline__ void rwkv_post(const Params& p) {
  const hf* P = (const hf*)(p.ws + OFF_RB);
  const hf* y0 = (const hf*)(p.ws + OFF_RA); const hf* y1 = y0 + (size_t)T_TOK * 1024;
  const hf* g16 = (const hf*)(p.ws + OFF_US5);
  const float* bonus = (const float*)(p.ws + OFF_SMALL + SM_BONUS);
  hf* mix = (hf*)(p.ws + OFF_MIX0);
  const float* mu = p.in[10];
  const int lane = tidx() & 63, gw = blockIdx.x * 4 + (tidx() >> 6), nw = gridDim.x * 4;
  for (int t = gw; t < T_TOK; t += nw) {
    int sq = seq_of(t), pos = t - seq_start(sq), L = seq_len(sq);
    int ch0 = lane * 16, head = lane >> 2;
    float y[16]; float sum = 0.f;
#pragma unroll
    for (int q = 0; q < 2; ++q) {
      h8 a = *(const h8*)(y0 + (size_t)t * 1024 + ch0 + q * 8), bq = *(const h8*)(y1 + (size_t)t * 1024 + ch0 + q * 8);
#pragma unroll
      for (int e = 0; e < 8; ++e) { y[q * 8 + e] = (float)a[e] + (float)bq[e]; sum += y[q * 8 + e]; }
    }
    sum += shx(sum, 1); sum += shx(sum, 2);
    float mean = sum * (1.f / 64.f), var = 0.f;
#pragma unroll
    for (int e = 0; e < 16; ++e) { float dd = y[e] - mean; var += dd * dd; }
    var += shx(var, 1); var += shx(var, 2);
    float rs = rsqrtf(var * (1.f / 64.f) + 64e-5f);
    float bon = bonus[((size_t)t * 16 + head) * 2] + bonus[((size_t)t * 16 + head) * 2 + 1];
#pragma unroll
    for (int q = 0; q < 2; ++q) {
      int col = 2048 + ch0 + q * 8;
      h8 cv = *(const h8*)(P + (size_t)t * 3456 + col), pv, nv;
      for (int e = 0; e < 8; ++e) { pv[e] = (hf)0; nv[e] = (hf)0; }
      if (pos > 0) pv = *(const h8*)(P + (size_t)(t - 1) * 3456 + col);
      if (pos < L - 1) nv = *(const h8*)(P + (size_t)(t + 1) * 3456 + col);
      h8 gg = *(const h8*)(g16 + (size_t)t * 1024 + ch0 + q * 8), o;
#pragma unroll
      for (int e = 0; e < 8; ++e) {
        int ch = ch0 + q * 8 + e;
        float cu = (float)cv[e]; float vm = cu + mu[col + e] * (0.5f * ((float)pv[e] + (float)nv[e]) - cu);
        float yn = (y[q * 8 + e] - mean) * rs * p.in[19][ch] + p.in[20][ch] + bon * vm;
        o[e] = (hf)(yn * (float)gg[e]);
      }
      *(h8*)(mix + (size_t)t * 2048 + ch0 + q * 8) = o;
    }
  }
}

__device__ __forceinline__ void convact_phase(const Params& p, int layer, int slab) {
  const hf* __restrict__ U = (const hf*)(p.ws + OFF_RB); hf* __restrict__ act = (hf*)(p.ws + OFF_ACT);
  const float* cw = p.in[44] + (size_t)layer * 3 * 11264; const float* cb = p.in[45] + (size_t)layer * 11264;
  const int lmask = slab == 2 ? 16383 : 8191;
  const int N = 16384 * 704, stride = gridDim.x * 256;
  for (int idx0 = blockIdx.x * 256 + tidx(); idx0 < N; idx0 += 2 * stride) {
    h8 cv[2][2], pv[2][2], nv[2][2]; int rowv[2], f0v[2];
    const bool ok1 = idx0 + stride < N;
#pragma unroll
    for (int u = 0; u < 2; ++u) {
      const int idx = (u == 0 || ok1) ? idx0 + u * stride : idx0;
      const int row = idx / 704, f0 = (idx - row * 704) * 8, pos = row & lmask;
      rowv[u] = row; f0v[u] = f0;
#pragma unroll
      for (int hh = 0; hh < 2; ++hh) {
        const int col = f0 + hh * 5632;
        cv[u][hh] = *(const h8*)(U + (size_t)row * 11264 + col);
#pragma unroll
        for (int e = 0; e < 8; ++e) { pv[u][hh][e] = (hf)0; nv[u][hh][e] = (hf)0; }
        if (pos > 0) pv[u][hh] = *(const h8*)(U + (size_t)(row - 1) * 11264 + col);
        if (pos < lmask) nv[u][hh] = *(const h8*)(U + (size_t)(row + 1) * 11264 + col);
      }
    }
#pragma unroll
    for (int u = 0; u < 2; ++u) {
      if (u == 1 && !ok1) break;
      float res[2][8];
#pragma unroll
      for (int hh = 0; hh < 2; ++hh) {
        const int col = f0v[u] + hh * 5632;
#pragma unroll
        for (int e = 0; e < 8; ++e)
          res[hh][e] = (float)pv[u][hh][e] * cw[col + e] + (float)cv[u][hh][e] * cw[11264 + col + e] + (float)nv[u][hh][e] * cw[22528 + col + e] + cb[col + e];
      }
      h8 o;
#pragma unroll
      for (int e = 0; e < 8; ++e) { float gt = res[1][e]; o[e] = (hf)(gt * sigmoidf_(gt) * res[0][e]); }
      *(h8*)(act + (size_t)rowv[u] * 5632 + f0v[u]) = o;
    }
  }
}

__device__ __forceinline__ void mla_prep(const Params& p) {
  const hf* p1 = (const hf*)(p.ws + OFF_RB);
  hf* cqn = (hf*)(p.ws + OFF_MIX1); hf* ckvn = (hf*)(p.ws + OFF_MIX1 + 48 * MiB);
  hf* km = (hf*)(p.ws + OFF_RA + 72 * MiB);
  const int lane = tidx() & 63, gw = blockIdx.x * 4 + (tidx() >> 6), nw = gridDim.x * 4;
  if (blockIdx.x == 0 && tidx() == 0) {
    float s1 = 0.f, s2 = 0.f;
    for (int i = 0; i < 64; ++i) { s1 += p.in[37][i] * p.in[38][i]; s2 += p.in[39][i] * p.in[40][i]; }
    float* lamp = (float*)(p.ws + OFF_SMALL + SM_CNT) + 8;
    lamp[0] = __expf(s1) - __expf(s2) + 0.35550906759f;
  }
  for (int t = gw; t < T_TOK; t += nw) {
    const hf* row = p1 + (size_t)t * 2848;
    h8 a = *(const h8*)(row + lane * 8); float ss = 0.f;
#pragma unroll
    for (int e = 0; e < 8; ++e) ss += (float)a[e] * (float)a[e];
#pragma unroll
    for (int o = 32; o; o >>= 1) ss += shx(ss, o);
    float r = rsqrtf(ss * (1.f / 512.f) + 1e-6f); h8 o8;
#pragma unroll
    for (int e = 0; e < 8; ++e) o8[e] = (hf)((float)a[e] * r * p.in[33][lane * 8 + e]);
    *(h8*)(cqn + (size_t)t * 512 + lane * 8) = o8;
    h4 b4 = *(const h4*)(row + 512 + lane * 4); float s2 = 0.f;
#pragma unroll
    for (int e = 0; e < 4; ++e) s2 += (float)b4[e] * (float)b4[e];
#pragma unroll
    for (int o = 32; o; o >>= 1) s2 += shx(s2, o);
    float r2 = rsqrtf(s2 * (1.f / 256.f) + 1e-6f); h4 o4;
#pragma unroll
    for (int e = 0; e < 4; ++e) o4[e] = (hf)((float)b4[e] * r2 * p.in[34][lane * 4 + e]);
    *(h4*)(ckvn + (size_t)t * 256 + lane * 4) = o4;
    if (lane < 16) {
      int pos = t - seq_start(seq_of(t));
      float inv = exp2f(-(float)lane * 0.830482023721841f);
      float sn, cs; sincos_red((float)pos * inv, sn, cs);
      float x1 = (float)row[768 + lane], x2 = (float)row[784 + lane];
      hf o1 = (hf)(x1 * cs - x2 * sn), o2 = (hf)(x1 * sn + x2 * cs);
#pragma unroll
      for (int h = 0; h < 8; ++h) { km[((size_t)t * 8 + h) * 96 + 64 + lane] = o1; km[((size_t)t * 8 + h) * 96 + 80 + lane] = o2; }
    }
  }
}

__device__ __forceinline__ void q_rope(const Params& p) {
  hf* qm = (hf*)(p.ws + OFF_RA);
  for (int idx = blockIdx.x * 256 + tidx(); idx < T_TOK * 128; idx += gridDim.x * 256) {
    int t = idx >> 7, h = (idx >> 4) & 7, i = idx & 15;
    int pos = t - seq_start(seq_of(t));
    float inv = exp2f(-(float)i * 0.830482023721841f);
    float sn, cs; sincos_red((float)pos * inv, sn, cs);
    hf* a = qm + ((size_t)t * 8 + h) * 96 + 64 + i;
    float x1 = (float)a[0], x2 = (float)a[16];
    a[0] = (hf)(x1 * cs - x2 * sn); a[16] = (hf)(x1 * sn + x2 * cs);
  }
}

constexpr int A_STG = 64 * 104 + 128 * 72;
template <int DQK, bool BIAS>
__device__ __forceinline__ void attn_pass(const hf* __restrict__ Q, int ldq, const hf* __restrict__ Kp, int ldk, const hf* __restrict__ VT,
                                          int s0, int L, int q0, float scale_l2, const float* sBias, f4 (&oacc)[8][4], char* smem) {
  constexpr int KS = DQK + 8, NKS = DQK / 32, NKL = DQK / 32;
  hf* sbase = (hf*)smem;
  const int tid = tidx(), lane = tid & 63, wv = tid >> 6, fr = lane & 15, fq = lane >> 4;
  h8 qf[4][NKS];
#pragma unroll
  for (int nq = 0; nq < 4; ++nq)
#pragma unroll
    for (int ks = 0; ks < NKS; ++ks) qf[nq][ks] = *(const h8*)(Q + (size_t)(s0 + q0 + wv * 64 + nq * 16 + fr) * ldq + ks * 32 + fq * 8);
  float mrun[4], lrun[4];
#pragma unroll
  for (int nq = 0; nq < 4; ++nq) { mrun[nq] = -1e30f; lrun[nq] = 0.f; }
#pragma unroll
  for (int md = 0; md < 8; ++md)
#pragma unroll
    for (int nq = 0; nq < 4; ++nq) oacc[md][nq] = (f4){0.f, 0.f, 0.f, 0.f};
  u4 rk[NKL], rv[4];
  auto loadKV = [&](int kt) {
    const int key0 = kt * 64;
#pragma unroll
    for (int i = 0; i < NKL; ++i) rk[i] = *(const u4*)(Kp + (size_t)(s0 + key0 + (tid >> 2)) * ldk + ((tid & 3) + 4 * i) * 8);
#pragma unroll
    for (int i = 0; i < 4; ++i) { int idx = tid + 256 * i, dv = idx >> 3, ch = idx & 7; rv[i] = *(const u4*)(VT + (size_t)dv * T_TOK + s0 + key0 + ch * 8); }
  };
  auto storeKV = [&](int st) {
    hf* sK = sbase + st * A_STG; hf* sVT = sK + 64 * 104;
#pragma unroll
    for (int i = 0; i < NKL; ++i) *(u4*)(sK + (tid >> 2) * KS + (((tid & 3) ^ (((tid >> 4) ^ (tid >> 5)) & 1)) + 4 * i) * 8) = rk[i];
#pragma unroll
    for (int i = 0; i < 4; ++i) { int idx = tid + 256 * i, dv = idx >> 3, ch = idx & 7; *(u4*)(sVT + dv * 72 + ch * 8) = rv[i]; }
  };
  const int nkt = L >> 6;
  __syncthreads();
  loadKV(0); storeKV(0);
  if (nkt > 1) loadKV(1);
  __syncthreads();
  for (int kt = 0; kt < nkt; ++kt) {
    const hf* sK = sbase + (kt & 1) * A_STG; const hf* sVT = sK + 64 * 104;
    f4 sacc[4][4];
#pragma unroll
    for (int mk = 0; mk < 4; ++mk) {
      h8 kf[NKS];
#pragma unroll
      for (int ks = 0; ks < NKS; ++ks) kf[ks] = *(const h8*)(sK + (mk * 16 + fr) * KS + ks * 32 + (fq ^ (((fr >> 2) ^ (fr >> 3)) & 1)) * 8);
#pragma unroll
      for (int nq = 0; nq < 4; ++nq) {
        f4 a = {0.f, 0.f, 0.f, 0.f};
#pragma unroll
        for (int ks = 0; ks < NKS; ++ks) a = mfma16(kf[ks], qf[nq][ks], a);
        sacc[mk][nq] = a;
      }
    }
    if (kt + 1 < nkt) storeKV((kt + 1) & 1);
    if (kt + 2 < nkt) loadKV(kt + 2);
    h8 pf[4][2];
    const int key0 = kt * 64;
    bool uni = true; float add = 0.f;
    if (BIAS) {
      const int dmin = key0 - (q0 + 255), dmax = key0 + 63 - q0;
      uni = (dmax <= -91) || (dmin >= 91);
      add = dmax <= -91 ? sBias[0] : sBias[256];
    }
#pragma unroll
    for (int nq = 0; nq < 4; ++nq) {
      if (BIAS) {
        if (uni) {
#pragma unroll
          for (int mk = 0; mk < 4; ++mk)
#pragma unroll
            for (int j = 0; j < 4; ++j) sacc[mk][nq][j] = sacc[mk][nq][j] * scale_l2 + add;
        } else {
#pragma unroll
          for (int mk = 0; mk < 4; ++mk)
#pragma unroll
            for (int j = 0; j < 4; ++j) {
              int rel = (key0 + mk * 16 + fq * 4 + j) - (q0 + wv * 64 + nq * 16 + fr);
              rel = min(max(rel, -128), 128);
              sacc[mk][nq][j] = sacc[mk][nq][j] * scale_l2 + sBias[rel + 128];
            }
        }
      }
      float mx = -1e30f;
#pragma unroll
      for (int mk = 0; mk < 4; ++mk) { mx = max3_(mx, sacc[mk][nq][0], sacc[mk][nq][1]); mx = max3_(mx, sacc[mk][nq][2], sacc[mk][nq][3]); }
      mx = max3_(mx, shx(mx, 16), mx); mx = max3_(mx, shx(mx, 32), mx);
      if (!BIAS) mx *= scale_l2;
      const bool upd = mx > mrun[nq] + 8.f;
      const float mnew = upd ? mx : mrun[nq];
      if (__builtin_amdgcn_ballot_w64(upd) != 0) {
        const float alpha = __builtin_amdgcn_exp2f(mrun[nq] - mnew);
        lrun[nq] *= alpha;
#pragma unroll
        for (int md = 0; md < 8; ++md) { oacc[md][nq][0] *= alpha; oacc[md][nq][1] *= alpha; oacc[md][nq][2] *= alpha; oacc[md][nq][3] *= alpha; }
      }
      mrun[nq] = mnew;
      float ps = 0.f;
#pragma unroll
      for (int mk = 0; mk < 4; ++mk)
#pragma unroll
        for (int j = 0; j < 4; ++j) {
          float pe = BIAS ? __builtin_amdgcn_exp2f(sacc[mk][nq][j] - mnew) : __builtin_amdgcn_exp2f(sacc[mk][nq][j] * scale_l2 - mnew);
          sacc[mk][nq][j] = pe; ps += pe;
        }
      lrun[nq] += ps;
#pragma unroll
      for (int s2 = 0; s2 < 2; ++s2)
#pragma unroll
        for (int i = 0; i < 8; ++i) pf[nq][s2][i] = (hf)sacc[2 * s2 + (i >> 2)][nq][i & 3];
    }
#pragma unroll
    for (int mh = 0; mh < 2; ++mh) {
      h8 vf[4][2];
#pragma unroll
      for (int m4 = 0; m4 < 4; ++m4)
#pragma unroll
        for (int s2 = 0; s2 < 2; ++s2) {
          h4 v0 = *(const h4*)(sVT + ((mh * 4 + m4) * 16 + fr) * 72 + s2 * 32 + fq * 4);
          h4 v1 = *(const h4*)(sVT + ((mh * 4 + m4) * 16 + fr) * 72 + s2 * 32 + 16 + fq * 4);
          vf[m4][s2] = __builtin_shufflevector(v0, v1, 0, 1, 2, 3, 4, 5, 6, 7);
        }
#pragma unroll
      for (int nq = 0; nq < 4; ++nq)
#pragma unroll
        for (int m4 = 0; m4 < 4; ++m4) {
          oacc[mh * 4 + m4][nq] = mfma16(vf[m4][0], pf[nq][0], oacc[mh * 4 + m4][nq]);
          oacc[mh * 4 + m4][nq] = mfma16(vf[m4][1], pf[nq][1], oacc[mh * 4 + m4][nq]);
        }
    }
    __syncthreads();
  }
#pragma unroll
  for (int nq = 0; nq < 4; ++nq) {
    float lt = lrun[nq]; lt += shx(lt, 16); lt += shx(lt, 32);
    const float inv = 1.f / lt;
#pragma unroll
    for (int md = 0; md < 8; ++md) { oacc[md][nq][0] *= inv; oacc[md][nq][1] *= inv; oacc[md][nq][2] *= inv; oacc[md][nq][3] *= inv; }
  }
}

__device__ __forceinline__ void attn_phase(const Params& p, char* smem, int coff) {
  __shared__ int sItem;
  int* counter = (int*)(p.ws + OFF_SMALL + SM_CNT) + coff;
  const float lam = ((const float*)(p.ws + OFF_SMALL + SM_CNT))[8];
  float* sBias = (float*)(smem + 2 * A_STG * 2);
  const hf* p1 = (const hf*)(p.ws + OFF_RB);
  const hf* vtd = (const hf*)(p.ws + OFF_VTD); const hf* vtm = (const hf*)(p.ws + OFF_VTM);
  const hf* qm = (const hf*)(p.ws + OFF_RA); const hf* km = (const hf*)(p.ws + OFF_RA + 72 * MiB);
  hf* mix = (hf*)(p.ws + OFF_MIX1);
  const int tid = tidx(), lane = tid & 63, wv = tid >> 6, fr = lane & 15, fq = lane >> 4;
  while (true) {
    __syncthreads();
    if (tid == 0) sItem = atomicAdd(counter, 1);
    __syncthreads();
    const int item = sItem;
    if (item >= 1536) break;
    int seq, h, qt;
    if (item < 512) { seq = 4; h = item >> 6; qt = item & 63; }
    else { int it = item - 512; seq = it >> 8; h = (it >> 5) & 7; qt = it & 31; }
    const int s0 = seq_start(seq), L = seq_len(seq), q0 = qt * 256;
    for (int i = tid; i < 257; i += 256) {
      int rel = i - 128, n = rel < 0 ? -rel : rel;
      int bk = n < 8 ? n : (n < 12 ? 8 : n < 16 ? 9 : n < 23 ? 10 : n < 32 ? 11 : n < 46 ? 12 : n < 64 ? 13 : n < 91 ? 14 : 15);
      if (rel > 0) bk += 16;
      sBias[i] = p.in[42][bk * 8 + h] * 1.44269504089f;
    }
#pragma unroll 1
    for (int m = 0; m < 2; ++m) {
      f4 oacc[8][4];
      attn_pass<64, true>(p1 + 800 + h * 128 + m * 64, 2848, p1 + 1824 + h * 128 + m * 64, 2848, vtd + (size_t)h * 128 * T_TOK, s0, L, q0,
                          0.125f * 1.44269504089f, sBias, oacc, smem);
      if (m == 0) {
#pragma unroll
        for (int nq = 0; nq < 4; ++nq)
#pragma unroll
          for (int md = 0; md < 8; ++md)
            *(h4*)(mix + (size_t)(s0 + q0 + wv * 64 + nq * 16 + fr) * 2048 + 1024 + h * 128 + md * 16 + fq * 4) = cvt4(oacc[md][nq]);
      } else {
#pragma unroll
        for (int nq = 0; nq < 4; ++nq) {
          hf* dst = mix + (size_t)(s0 + q0 + wv * 64 + nq * 16 + fr) * 2048 + 1024 + h * 128 + fq * 4;
          float ss = 0.f;
#pragma unroll
          for (int md = 0; md < 8; ++md) {
            h4 o0 = *(const h4*)(dst + md * 16);
#pragma unroll
            for (int j = 0; j < 4; ++j) { float o = (float)o0[j] - lam * oacc[md][nq][j]; oacc[md][nq][j] = o; ss += o * o; }
          }
          ss += shx(ss, 16); ss += shx(ss, 32);
          const float r = rsqrtf(ss * (1.f / 128.f) + 1e-5f) * (1.f - 0.35550906759f);
#pragma unroll
          for (int md = 0; md < 8; ++md) {
            f4 gg = *(const f4*)(p.in[41] + md * 16 + fq * 4); h4 o;
#pragma unroll
            for (int j = 0; j < 4; ++j) o[j] = (hf)(oacc[md][nq][j] * r * gg[j]);
            *(h4*)(dst + md * 16) = o;
          }
        }
      }
    }
  }
  while (true) {
    __syncthreads();
    if (tid == 0) sItem = atomicAdd(counter + 1, 1);
    __syncthreads();
    const int item = sItem;
    if (item >= 1536) break;
    int seq, h, qt;
    if (item < 512) { seq = 4; h = item >> 6; qt = item & 63; }
    else { int it = item - 512; seq = it >> 8; h = (it >> 5) & 7; qt = it & 31; }
    const int s0 = seq_start(seq), L = seq_len(seq), q0 = qt * 256;
    f4 oacc[8][4];
    attn_pass<96, false>(qm + h * 96, 768, km + h * 96, 768, vtm + (size_t)h * 128 * T_TOK, s0, L, q0, 0.10206207262f * 1.44269504089f, nullptr, oacc, smem);
#pragma unroll
    for (int nq = 0; nq < 4; ++nq)
#pragma unroll
      for (int md = 0; md < 8; ++md)
        *(h4*)(mix + (size_t)(s0 + q0 + wv * 64 + nq * 16 + fr) * 2048 + h * 128 + md * 16 + fq * 4) = cvt4(oacc[md][nq]);
  }
}

__device__ __forceinline__ void ffn_layer(const Params& p, cg::grid_group& grid, int layer, char* smem) {
  const hf* W = (const hf*)(p.ws + OFF_W);
  const hf* wup = W + (layer == 0 ? W0_FUP : W1_FUP); const hf* wdn = W + (layer == 0 ? W0_FDN : W1_FDN);
  const hf* h16 = (const hf*)(p.ws + OFF_RA);
  hf* u16 = (hf*)(p.ws + OFF_RB); hf* act = (hf*)(p.ws + OFF_ACT);
  const float* mod = (const float*)(p.ws + OFF_SMALL + SM_MOD) + (size_t)layer * 5 * 12288;
  gemm_run(GemmArgs{h16, 2048, 0, wup, 2048, 0, 16384, 11264, 2048, 1}, EpiStore{u16, 11264}, smem);
  grid.sync();
#pragma unroll
  for (int slab = 0; slab < 3; ++slab) {
    convact_phase(p, layer, slab);
    grid.sync();
    gemm_run(GemmArgs{act, 5632, 0, wdn, 5632, 0, 16384, 2048, 5632, 1}, EpiResid{p.out, mod + 5 * 2048, slab * 16384}, smem);
    if (slab < 2)
      gemm_run(GemmArgs{h16 + (size_t)(slab + 1) * 16384 * 2048, 2048, 0, wup, 2048, 0, 16384, 11264, 2048, 1}, EpiStore{u16, 11264}, smem);
    grid.sync();
  }
}

__global__ void __launch_bounds__(256, 1) mega(Params p) {
  cg::grid_group grid = cg::this_grid();
  extern __shared__ __attribute__((aligned(16))) char smem[];
  hf* W = (hf*)(p.ws + OFF_W);
  float* mod = (float*)(p.ws + OFF_SMALL + SM_MOD);

  if (blockIdx.x == 0 && tidx() == 0) { int* cnt = (int*)(p.ws + OFF_SMALL + SM_CNT); cnt[0] = 0; cnt[1] = 0; cnt[2] = 0; cnt[3] = 0; }
  adaln_phase(p, smem);
  s5_tabA(p, smem);
  cvt_t(p.in[8], W + W0_IN, 2048, 4480, smem);
  cvt_t(p.in[9], W + W0_OUT, 2048, 2048, smem);
  cvt_t(p.in[29], W + W0_GLU, 1024, 1024, smem);
  cvt_t(p.in[15], W + W0_GUP, 128, 1024, smem);
  cvt_t(p.in[43], W + W0_FUP, 2048, 11264, smem);
  cvt_t(p.in[46], W + W0_FDN, 5632, 2048, smem);
  grid.sync();
  norm_phase(p, 0, 0, true);
  s5_tabB(p);
#ifdef DUP_EW
  norm_phase(p, 0, 0, true);
  s5_tabB(p);
#endif
  grid.sync();
  gemm_run(GemmArgs{(const hf*)(p.ws + OFF_RA), 2048, 0, W + W0_IN, 2048, 0, T_TOK, 4480, 2048, 1},
           EpiInproj0{(hf*)(p.ws + OFF_RB), (hf*)(p.ws + OFF_US5)}, smem);
  grid.sync();
  gemm_run(GemmArgs{(const hf*)(p.ws + OFF_US5), 768, (size_t)1536 * 768, (const hf*)(p.ws + OFF_S5M), 512, (size_t)256 * 512, 1536, 256, 512, 64},
           EpiS5p1{(float*)(p.ws + OFF_RA)}, smem);
  grid.sync();
  s5_carry(p);
#ifdef DUP_EW
  s5_carry(p);
#endif
  grid.sync();
  gemm_run(GemmArgs{(const hf*)(p.ws + OFF_US5), 768, (size_t)1536 * 768, (const hf*)(p.ws + OFF_S5M + 16 * MiB), 768, (size_t)512 * 768, 1536, 512, 768, 64},
           EpiS5p2{(hf*)(p.ws + OFF_RA + 96 * MiB)}, smem);
  grid.sync();
  gemm_run(GemmArgs{(const hf*)(p.ws + OFF_RA + 96 * MiB), 1024, 0, W + W0_GLU, 1024, 0, T_TOK, 1024, 1024, 1},
           EpiGlu{(const hf*)(p.ws + OFF_RA + 96 * MiB), p.in[30], (hf*)(p.ws + OFF_MIX0)}, smem);
  gate_prep(p);
#ifdef DUP_EW
  gate_prep(p);
#endif
  grid.sync();
  gemm_run(GemmArgs{(const hf*)(p.ws + OFF_US5 + 96 * MiB), 128, 0, W + W0_GUP, 128, 0, T_TOK, 1024, 128, 1},
           EpiStore{(hf*)(p.ws + OFF_US5), 1024}, smem);
  rwkv_scan_phase(p, smem);
#ifdef DUP_RWKV
  grid.sync();
  rwkv_scan_phase(p, smem);
#endif
  grid.sync();
  rwkv_post(p);
#ifdef DUP_EW
  rwkv_post(p);
#endif
  grid.sync();
  gemm_run(GemmArgs{(const hf*)(p.ws + OFF_MIX0), 2048, 0, W + W0_OUT, 2048, 0, T_TOK, 2048, 2048, 1},
           EpiResid{p.out, mod + 2 * 2048, 0}, smem);
  grid.sync();
  norm_phase(p, 0, 1, false);
#ifdef DUP_EW
  norm_phase(p, 0, 1, false);
#endif
  grid.sync();
  ffn_layer(p, grid, 0, smem);
  cvt_t(p.in[31], W + W1_IN, 2048, 3872, smem);
  cvt_t(p.in[32], W + W1_OUT, 2048, 2048, smem);
  cvt_t(p.in[35], W + W1_UQ, 512, 768, smem);
  cvt_t(p.in[36], W + W1_UKV, 256, 1536, smem);
  cvt_t(p.in[43] + (size_t)2048 * 11264, W + W1_FUP, 2048, 11264, smem);
  cvt_t(p.in[46] + (size_t)5632 * 2048, W + W1_FDN, 5632, 2048, smem);
  norm_phase(p, 1, 0, false);
#ifdef DUP_EW
  norm_phase(p, 1, 0, false);
#endif
  grid.sync();
  gemm_run(GemmArgs{(const hf*)(p.ws + OFF_RA), 2048, 0, W + W1_IN, 2048, 0, T_TOK, 3872, 2048, 1},
           EpiInproj1{(hf*)(p.ws + OFF_RB), (hf*)(p.ws + OFF_VTD)}, smem);
  grid.sync();
  mla_prep(p);
#ifdef DUP_EW
  mla_prep(p);
#endif
  grid.sync();
  gemm_run(GemmArgs{(const hf*)(p.ws + OFF_MIX1), 512, 0, W + W1_UQ, 512, 0, T_TOK, 768, 512, 1},
           EpiStore{(hf*)(p.ws + OFF_RA), 768}, smem);
  gemm_run(GemmArgs{(const hf*)(p.ws + OFF_MIX1 + 48 * MiB), 256, 0, W + W1_UKV, 256, 0, T_TOK, 1536, 256, 1},
           EpiUkv{(hf*)(p.ws + OFF_RA + 72 * MiB), (hf*)(p.ws + OFF_VTM)}, smem);
  grid.sync();
  q_rope(p);
  grid.sync();
  attn_phase(p, smem, 0);
#ifdef DUP_ATTN
  grid.sync();
  attn_phase(p, smem, 2);
#endif
  grid.sync();
  gemm_run(GemmArgs{(const hf*)(p.ws + OFF_MIX1), 2048, 0, W + W1_OUT, 2048, 0, T_TOK, 2048, 2048, 1},
           EpiResid{p.out, mod + (size_t)5 * 12288 + 2 * 2048, 0}, smem);
  grid.sync();
  norm_phase(p, 1, 1, false);
#ifdef DUP_EW
  norm_phase(p, 1, 1, false);
#endif
  grid.sync();
  ffn_layer(p, grid, 1, smem);
  final_norm(p);
}

extern "C" void kernel_launch(void* const* d_in, const int* in_sizes, int n_in, void* d_out, int out_size,
                              void* d_ws, size_t ws_size, hipStream_t stream) {
  static int grid_blocks = 0;
  if (!grid_blocks) {
    int dev = 0, cus = 0, per_cu = 0;
    (void)hipGetDevice(&dev);
    (void)hipDeviceGetAttribute(&cus, hipDeviceAttributeMultiprocessorCount, dev);
    (void)hipFuncSetAttribute((const void*)mega, hipFuncAttributeMaxDynamicSharedMemorySize, DYN_LDS);
    (void)hipOccupancyMaxActiveBlocksPerMultiprocessor(&per_cu, mega, 256, DYN_LDS);
    if (per_cu > 2) per_cu = 2;
    if (per_cu < 1) per_cu = 1;
    grid_blocks = cus * per_cu;
  }
  Params p{};
  for (int i = 0; i < 48; ++i) p.in[i] = (const float*)d_in[i];
  p.out = (float*)d_out; p.ws = (char*)d_ws; p.stop = STOP_AT;
  void* args[] = {&p};
  hipError_t e = hipLaunchCooperativeKernel((void*)mega, dim3(grid_blocks), dim3(256), args, DYN_LDS, stream);
  if (e != hipSuccess) fprintf(stderr, "cooperative launch failed: %s (grid %d)\n", hipGetErrorString(e), grid_blocks);
}
```
